# Optimizing an MI355X kernel written in HIP

```python
import jax, jax.numpy as jnp
from jax import lax
import numpy as np

D_MODEL = 1024
BATCH = 16
SEQ = 2048
DEPTH = 1

N_MEM = 256
EPS = 1e-6
NEG_INF = -1e30
D_FF = 2816
N_HEADS_A = 8
D_QK = 64
D_V = 64
Q_LORA = 256
KV_LORA = 256
N_IDX = 4
D_IDX = 64
TOPK_MAX = 256
Q_BLOCK = 128
CONV_CH = 512
CONV_WIDTH = 31
N_HEADS_M = 4
D_HEAD_M = 128
N_BRANCH = 3
SPLITS = (Q_LORA, KV_LORA, D_IDX, N_IDX, 2 * CONV_CH, N_HEADS_M * D_HEAD_M, N_BRANCH * D_MODEL)
D_IN = sum(SPLITS)

kernel_name = "hybrid_dsa_conformer_memory_block"


def rms_norm(x, g):
    xf = x.astype(jnp.float32)
    y = xf * lax.rsqrt(jnp.mean(xf * xf, axis=-1, keepdims=True) + EPS)
    return (y * g.astype(jnp.float32)).astype(x.dtype)


def layer_norm(x, g, b):
    xf = x.astype(jnp.float32)
    mu = jnp.mean(xf, axis=-1, keepdims=True)
    xc = xf - mu
    var = jnp.mean(xc * xc, axis=-1, keepdims=True)
    return (xc * lax.rsqrt(var + EPS) * g.astype(jnp.float32) + b.astype(jnp.float32)).astype(x.dtype)


def half_step_ffn(x, g_pre, g_post, w_gu, w_down):
    gate, up = jnp.split(rms_norm(x, g_pre) @ w_gu, 2, axis=-1)
    return x + 0.5 * rms_norm((jax.nn.silu(gate) * up) @ w_down, g_post)


def dsa_attention(h, c_q, c_kv, k_idx_raw, w_idx_raw, q_norm_g, kv_norm_g, w_uq, w_uk, w_uv,
                  w_idx_q, idx_ln_g, idx_ln_b):
    B, T, _ = h.shape
    topk = min(TOPK_MAX, T // 4)
    cq = rms_norm(c_q, q_norm_g)
    ckv = rms_norm(c_kv, kv_norm_g)
    q = (cq @ w_uq).reshape(B, T, N_HEADS_A, D_QK)
    q_lat = jnp.einsum('bthd,chd->bthc', q, w_uk) * (D_QK ** -0.5)
    q_idx = ((cq @ w_idx_q) * (D_IDX ** -0.5)).reshape(B, T, N_IDX, D_IDX).astype(jnp.float32)
    k_idx = layer_norm(k_idx_raw, idx_ln_g, idx_ln_b).astype(jnp.float32)
    w_idx = (w_idx_raw * (N_IDX ** -0.5)).astype(jnp.float32)
    key_pos = jnp.arange(T)

    def block(start):
        qi = lax.dynamic_slice_in_dim(q_idx, start, Q_BLOCK, axis=1)
        wi = lax.dynamic_slice_in_dim(w_idx, start, Q_BLOCK, axis=1)
        ql = lax.dynamic_slice_in_dim(q_lat, start, Q_BLOCK, axis=1)
        qpos = start + jnp.arange(Q_BLOCK)
        logits = jnp.einsum('bqhd,bsd->bqhs', qi, k_idx)
        score = jnp.einsum('bqh,bqhs->bqs', wi, jax.nn.relu(logits))
        causal = key_pos[None, :] <= qpos[:, None]
        score = jnp.where(causal[None], score, NEG_INF)
        _, sel = lax.top_k(score, topk)
        valid = sel <= qpos[None, :, None]
        kv_sel = jax.vmap(lambda c, i: c[i])(ckv, sel)
        s = jnp.einsum('bqhc,bqkc->bqhk', ql, kv_sel).astype(jnp.float32)
        s = jnp.where(valid[:, :, None, :], s, NEG_INF)
        p = jax.nn.softmax(s, axis=-1).astype(kv_sel.dtype)
        o_lat = jnp.einsum('bqhk,bqkc->bqhc', p, kv_sel)
        o = jnp.einsum('bqhc,chd->bqhd', o_lat, w_uv)
        return o.reshape(B, Q_BLOCK, N_HEADS_A * D_V)

    starts = jnp.arange(T // Q_BLOCK) * Q_BLOCK
    out = lax.map(block, starts)
    return out.transpose(1, 0, 2, 3).reshape(B, T, N_HEADS_A * D_V)


def conv_module(u_glu, w_dw, b_dw, ln_g, ln_b, w_pw_out):
    a, g = jnp.split(u_glu, 2, axis=-1)
    u = a * jax.nn.sigmoid(g)
    y = lax.conv_general_dilated(
        u, w_dw[:, None, :].astype(u.dtype), window_strides=(1,),
        padding=((CONV_WIDTH - 1, 0),), dimension_numbers=('NWC', 'WIO', 'NWC'),
        feature_group_count=CONV_CH) + b_dw
    return jax.nn.silu(layer_norm(y, ln_g, ln_b)) @ w_pw_out


def memory_attention(q_raw, mem, mem_norm_g, w_mem_kv):
    B, T, _ = q_raw.shape
    M = mem.shape[1]
    q = q_raw.reshape(B, T, N_HEADS_M, D_HEAD_M)
    k, v = jnp.split(rms_norm(mem, mem_norm_g) @ w_mem_kv, 2, axis=-1)
    k = k.reshape(B, M, N_HEADS_M, D_HEAD_M)
    v = v.reshape(B, M, N_HEADS_M, D_HEAD_M)
    s = jnp.einsum('bthd,bmhd->bhtm', q, k).astype(jnp.float32) * (D_HEAD_M ** -0.5)
    p = jax.nn.softmax(s, axis=-1).astype(v.dtype)
    return jnp.einsum('bhtm,bmhd->bthd', p, v).reshape(B, T, N_HEADS_M * D_HEAD_M)


def hybrid_mixer(x, mem, mix_pre_g, mix_post_g, w_in,
                 q_norm_g, kv_norm_g, w_uq, w_uk, w_uv, w_idx_q, idx_ln_g, idx_ln_b, w_dsa_o,
                 w_dw, b_dw, conv_ln_g, conv_ln_b, w_conv_out,
                 mem_norm_g, w_mem_kv, w_mem_o, w_out):
    h = rms_norm(x, mix_pre_g)
    cuts = [int(c) for c in np.cumsum(SPLITS)[:-1]]
    c_q, c_kv, k_idx_raw, w_idx_raw, u_glu, q_mem, gate_logits = jnp.split(h @ w_in, cuts, axis=-1)
    y_a = dsa_attention(h, c_q, c_kv, k_idx_raw, w_idx_raw, q_norm_g, kv_norm_g, w_uq, w_uk, w_uv,
                        w_idx_q, idx_ln_g, idx_ln_b) @ w_dsa_o
    y_b = conv_module(u_glu, w_dw, b_dw, conv_ln_g, conv_ln_b, w_conv_out)
    y_m = memory_attention(q_mem, mem, mem_norm_g, w_mem_kv) @ w_mem_o
    g_a, g_b, g_m = jnp.split(jax.nn.sigmoid(gate_logits), N_BRANCH, axis=-1)
    merged = g_a * y_a + g_b * y_b + g_m * y_m
    return x + rms_norm(merged @ w_out, mix_post_g)


def setup_inputs(seed: int = 0) -> dict:
    key = jax.random.key(seed)
    ks = iter(jax.random.split(key, 40))

    def dense(shape, fan_in):
        return jax.random.normal(next(ks), (DEPTH,) + shape, jnp.float32) * (fan_in ** -0.5)

    def gain(n):
        return 1.0 + 0.02 * jax.random.normal(next(ks), (DEPTH, n), jnp.float32)

    def bias(n):
        return 0.02 * jax.random.normal(next(ks), (DEPTH, n), jnp.float32)

    x = jax.random.normal(next(ks), (BATCH, SEQ, D_MODEL), jnp.float32)
    mem = jax.random.normal(next(ks), (BATCH, N_MEM, D_MODEL), jnp.float32)
    return {
        "x": x, "mem": mem,
        "ffn1_pre_g": gain(D_MODEL), "ffn1_post_g": gain(D_MODEL),
        "ffn1_w_gu": dense((D_MODEL, 2 * D_FF), D_MODEL), "ffn1_w_down": dense((D_FF, D_MODEL), D_FF),
        "mix_pre_g": gain(D_MODEL), "mix_post_g": gain(D_MODEL),
        "w_in": dense((D_MODEL, D_IN), D_MODEL),
        "q_norm_g": gain(Q_LORA), "kv_norm_g": gain(KV_LORA),
        "w_uq": dense((Q_LORA, N_HEADS_A * D_QK), Q_LORA),
        "w_uk": dense((KV_LORA, N_HEADS_A, D_QK), KV_LORA),
        "w_uv": dense((KV_LORA, N_HEADS_A, D_V), KV_LORA),
        "w_idx_q": dense((Q_LORA, N_IDX * D_IDX), Q_LORA),
        "idx_ln_g": gain(D_IDX), "idx_ln_b": bias(D_IDX),
        "w_dsa_o": dense((N_HEADS_A * D_V, D_MODEL), N_HEADS_A * D_V),
        "w_dw": dense((CONV_WIDTH, CONV_CH), CONV_WIDTH), "b_dw": bias(CONV_CH),
        "conv_ln_g": gain(CONV_CH), "conv_ln_b": bias(CONV_CH),
        "w_conv_out": dense((CONV_CH, D_MODEL), CONV_CH),
        "mem_norm_g": gain(D_MODEL),
        "w_mem_kv": dense((D_MODEL, 2 * N_HEADS_M * D_HEAD_M), D_MODEL),
        "w_mem_o": dense((N_HEADS_M * D_HEAD_M, D_MODEL), N_HEADS_M * D_HEAD_M),
        "w_out": dense((D_MODEL, D_MODEL), D_MODEL),
        "ffn2_pre_g": gain(D_MODEL), "ffn2_post_g": gain(D_MODEL),
        "ffn2_w_gu": dense((D_MODEL, 2 * D_FF), D_MODEL), "ffn2_w_down": dense((D_FF, D_MODEL), D_FF),
    }


def reference(x, mem, ffn1_pre_g, ffn1_post_g, ffn1_w_gu, ffn1_w_down,
              mix_pre_g, mix_post_g, w_in,
              q_norm_g, kv_norm_g, w_uq, w_uk, w_uv, w_idx_q, idx_ln_g, idx_ln_b, w_dsa_o,
              w_dw, b_dw, conv_ln_g, conv_ln_b, w_conv_out,
              mem_norm_g, w_mem_kv, w_mem_o, w_out,
              ffn2_pre_g, ffn2_post_g, ffn2_w_gu, ffn2_w_down):
    for l in range(DEPTH):
        x = half_step_ffn(x, ffn1_pre_g[l], ffn1_post_g[l], ffn1_w_gu[l], ffn1_w_down[l])
        x = hybrid_mixer(x, mem, mix_pre_g[l], mix_post_g[l], w_in[l],
                         q_norm_g[l], kv_norm_g[l], w_uq[l], w_uk[l], w_uv[l], w_idx_q[l],
                         idx_ln_g[l], idx_ln_b[l], w_dsa_o[l],
                         w_dw[l], b_dw[l], conv_ln_g[l], conv_ln_b[l], w_conv_out[l],
                         mem_norm_g[l], w_mem_kv[l], w_mem_o[l], w_out[l])
        x = half_step_ffn(x, ffn2_pre_g[l], ffn2_post_g[l], ffn2_w_gu[l], ffn2_w_down[l])
    return x
```

```cpp
#include <hip/hip_runtime.h>
#include <hip/hip_cooperative_groups.h>
#include <cstdio>
#include <cstdint>
#include <cmath>
#ifndef MK_ONE_LAUNCH
#define MK_ONE_LAUNCH 0
#endif
#ifndef MK_PHMASK
#define MK_PHMASK 0x3fff
#endif
#ifndef MK_P5MASK
#define MK_P5MASK 31
#endif
#ifndef MK_ZERO_DSA
#define MK_ZERO_DSA 0
#endif
#ifndef MK_ZERO_MEM
#define MK_ZERO_MEM 0
#endif
#ifndef MK_DEBUG
#define MK_DEBUG 0
#endif
#ifndef MK_DBG_SIG
#define MK_DBG_SIG 1
#endif
namespace pg8 {
#define PG8_LAS __attribute__((address_space(3)))
typedef unsigned short bf16_t;
typedef short bf16x8 __attribute__((ext_vector_type(8)));
typedef float f32x4 __attribute__((ext_vector_type(4)));
typedef unsigned u32x4 __attribute__((ext_vector_type(4)));
constexpr int BM = 256, BK = 64, HALF = 128, HTB = HALF * BK * 2  , STAGE_BYTES = 8 * HTB, NXCD = 8, WGM = 8;

__host__ __device__ __forceinline__ int lds_byte(int r, int c) { const int st = (r >> 4) * 2 + (c >> 5), rr = r & 15, cc = c & 31, ob = rr * 64 + cc * 2; return st * 1024 + (ob ^ (((ob >> 9) & 1) << 5)); }
__host__ __device__ __forceinline__ void stage_rc(int b, int& R, int& C) { const int st = b / 1024, sb = b % 1024, swz = sb ^ (((sb >> 9) & 1) << 5); R = (st >> 1) * 16 + swz / 64; C = (st & 1) * 32 + (swz % 64) / 2; }
__host__ __device__ __forceinline__ int perm32(int rho) { const int n = rho >> 4, i = rho & 15; return 8 * (i >> 2) + 4 * n + (i & 3); }

struct Unit { int pm, pn, seg; };
struct Gemm { const bf16_t* A; const bf16_t* Bt; int M, N, K, lda, ldb; };

struct StaticOrder {
    int nM, nN, nwg, G, c;
    __host__ __device__ void init(int M, int N, int G_, int c_) { nM = M / BM; nN = N / BM; nwg = nM * nN; G = G_; c = c_; }
    __host__ __device__ bool next(int i, Unit& u) const {
        const long L = (long)i * G + c; if (L >= nwg) return false;
        int wgid = (int)L; { const int q = nwg / NXCD, r = nwg % NXCD, xcd = wgid % NXCD, off = wgid / NXCD; wgid = (xcd < r ? xcd * (q + 1) : r * (q + 1) + (xcd - r) * q) + off; }
        const int nig = WGM * nN, gid = wgid / nig, fm = gid * WGM, gsz = (nM - fm) < WGM ? (nM - fm) : WGM;
        u.pm = fm + ((wgid % nig) % gsz); u.pn = (wgid % nig) / gsz; u.seg = 0; return true;
    }
    __device__ __forceinline__ void a_ready(const Unit&) const {}
    __device__ __forceinline__ void done(const Unit&) const {}
};
typedef float f32x2_cv __attribute__((ext_vector_type(2))); typedef __bf16 bf16x2_cv __attribute__((ext_vector_type(2)));
__device__ __forceinline__ unsigned cvt_pk_bf16(float lo, float hi) { const f32x2_cv v = {lo, hi}; return __builtin_bit_cast(unsigned, __builtin_convertvector(v, bf16x2_cv)); }
typedef float f32x2 __attribute__((ext_vector_type(2)));
template <class Epi, class Sched, bool ALIGN_EPI = false, bool SP2 = false>
__device__ __forceinline__ void gemm_phase(PG8_LAS unsigned char* lds, const Gemm g, const Sched& S, const Epi& E) {
    int tid_ = threadIdx.x; asm volatile("" : "+v"(tid_));
    const int tid = tid_, wid = __builtin_amdgcn_readfirstlane(tid >> 6), lane = tid & 63, wr = wid >> 2, wc = wid & 3, fr = lane & 15, fq = lane >> 4;
    const int K = g.K, nt = K / BK;
    unsigned voffA[2], voffB[2];
#pragma unroll
    for (int i = 0; i < 2; ++i) { int R, C; stage_rc(tid * 16 + i * 8192, R, C); const int Rb = Epi::PERM ? ((R & ~31) + perm32(R & 31)) : R;
        voffA[i] = (unsigned)(R * g.lda + C) * 2u; voffB[i] = (unsigned)(Rb * g.ldb + C) * 2u; }
    const size_t kstep = (size_t)(BK * 2);
    const size_t hstepB = (size_t)HALF * g.ldb * 2, hstepA = (size_t)HALF * g.lda * 2;
    const size_t tstepB = 2 * hstepB, tstepA = 2 * hstepA;
    const unsigned ldsw = (unsigned)wid * 1024u;
    const int aoff = lds_byte(wr * 64 + fr, fq * 8), boff = lds_byte(wc * 32 + fr, fq * 8);
#define PG8_SA(b, h) (((b) * 2 + (h)) * HTB)
#define PG8_SB(b, h) ((4 + (b) * 2 + (h)) * HTB)
#define PG8_STAGE(bufoff, gbase, voff) do { _Pragma("unroll") for (int _i = 0; _i < 2; ++_i) \
        __builtin_amdgcn_global_load_lds((const unsigned*)((const char*)(gbase) + (voff)[_i]), (PG8_LAS unsigned*)(lds + (bufoff) + ldsw + _i * 8192), 16, 0, 0); } while (0)
#define PG8_LDA(dst, b, h) do { _Pragma("unroll") for (int m = 0; m < 4; ++m) _Pragma("unroll") for (int k = 0; k < 2; ++k) dst[m][k] = *(const PG8_LAS bf16x8*)(lds + PG8_SA(b, h) + aoff + m * 2048 + k * 1024); } while (0)
#define PG8_LDB(dst, b, h) do { _Pragma("unroll") for (int n = 0; n < 2; ++n) _Pragma("unroll") for (int k = 0; k < 2; ++k) dst[n][k] = *(const PG8_LAS bf16x8*)(lds + PG8_SB(b, h) + boff + n * 2048 + k * 1024); } while (0)
#define PG8_MMA(ai, bj, At, Bt) do { __builtin_amdgcn_s_setprio(1); _Pragma("unroll") for (int m = 0; m < 4; ++m) _Pragma("unroll") for (int n = 0; n < 2; ++n) _Pragma("unroll") for (int k = 0; k < 2; ++k) \
        acc[ai][bj][m][n] = __builtin_amdgcn_mfma_f32_16x16x32_bf16(Bt[n][k], At[m][k], acc[ai][bj][m][n], 0, 0, 0); __builtin_amdgcn_s_setprio(0); } while (0)
#define PG8_WAIT_V(n) asm volatile("s_waitcnt vmcnt(" #n ")" ::: "memory")
#define PG8_WAIT_L(n) asm volatile("s_waitcnt lgkmcnt(" #n ")" ::: "memory")
#define PG8_BAR __builtin_amdgcn_s_barrier()
#define PG8_SCHED __builtin_amdgcn_sched_barrier(0)
    Unit cur, nxt; int ui = 0;
    if (!S.next(0, cur)) return;
    f32x4 acc[2][2][4][2];
#pragma unroll
    for (int a = 0; a < 2; ++a)
#pragma unroll
        for (int b = 0; b < 2; ++b)
#pragma unroll
            for (int m = 0; m < 4; ++m)
#pragma unroll
                for (int n = 0; n < 2; ++n) acc[a][b][m][n] = (f32x4){0.f, 0.f, 0.f, 0.f};
    bf16x8 At[4][2], B0[2][2], B1[2][2];
    const char* cA = (const char*)g.A + (size_t)cur.pm * tstepA + E.koff(cur); const char* cB = (const char*)g.Bt + (size_t)cur.pn * tstepB + E.koff(cur);
    S.a_ready(cur);
    if constexpr (SP2) {
        PG8_STAGE(PG8_SB(0, 0), cB, voffB); PG8_STAGE(PG8_SB(0, 1), cB + hstepB, voffB); PG8_STAGE(PG8_SA(0, 0), cA, voffA); PG8_STAGE(PG8_SA(0, 1), cA + hstepA, voffA);
        if (wr == 1) PG8_BAR;
        PG8_WAIT_V(2); PG8_BAR;
        PG8_STAGE(PG8_SB(1, 0), cB + kstep, voffB); PG8_STAGE(PG8_SA(1, 0), cA + kstep, voffA); PG8_STAGE(PG8_SB(1, 1), cB + hstepB + kstep, voffB);
        PG8_WAIT_V(6); PG8_BAR;
    } else {
        PG8_STAGE(PG8_SB(0, 0), cB, voffB); PG8_STAGE(PG8_SA(0, 0), cA, voffA); PG8_STAGE(PG8_SB(0, 1), cB + hstepB, voffB); PG8_STAGE(PG8_SA(0, 1), cA + hstepA, voffA);
        if (wr == 1) PG8_BAR;
        PG8_WAIT_V(4); PG8_BAR;
        PG8_STAGE(PG8_SB(1, 0), cB + kstep, voffB); PG8_STAGE(PG8_SA(1, 0), cA + kstep, voffA); PG8_STAGE(PG8_SB(1, 1), cB + hstepB + kstep, voffB);
        PG8_WAIT_V(6); PG8_BAR;
    }
    for (;;) {
        const bool has_next = S.next(ui + 1, nxt);
        const char* nA = has_next ? (const char*)g.A + (size_t)nxt.pm * tstepA + E.koff(nxt) : cA; const char* nB = has_next ? (const char*)g.Bt + (size_t)nxt.pn * tstepB + E.koff(nxt) : cB;
        for (int t = 0; t < nt; t += 2) {
            if constexpr (Epi::HAS_MID) E.mid(acc, cur, t, wr, wc, fr, fq);
            const bool last = (t == nt - 2);
            const char* a1 = cA + (size_t)(t + 1) * kstep;
            const char* a2 = last ? nA : cA + (size_t)(t + 2) * kstep; const char* b2 = last ? nB : cB + (size_t)(t + 2) * kstep;
            const char* a3 = a2 + kstep; const char* b3 = b2 + kstep;
            if (last && has_next) S.a_ready(nxt);
            if constexpr (SP2) {
            PG8_LDB(B0, 0, 0); PG8_LDB(B1, 0, 1); PG8_SCHED; PG8_LDA(At, 0, 0); PG8_STAGE(PG8_SA(1, 1), a1 + hstepA, voffA);
            PG8_WAIT_V(8); PG8_WAIT_L(0); PG8_BAR; PG8_MMA(0, 0, At, B0); PG8_MMA(0, 1, At, B1); PG8_BAR; PG8_SCHED;
            PG8_LDA(At, 0, 1); PG8_STAGE(PG8_SB(0, 0), b2, voffB); PG8_STAGE(PG8_SB(0, 1), b2 + hstepB, voffB); PG8_STAGE(PG8_SA(0, 0), a2, voffA);
            PG8_WAIT_V(8); PG8_WAIT_L(0); PG8_BAR; PG8_MMA(1, 0, At, B0); PG8_MMA(1, 1, At, B1); PG8_BAR; PG8_SCHED;
            PG8_LDB(B0, 1, 0); PG8_LDB(B1, 1, 1); PG8_SCHED; PG8_LDA(At, 1, 0); PG8_STAGE(PG8_SA(0, 1), a2 + hstepA, voffA);
            PG8_WAIT_V(8); PG8_WAIT_L(0); PG8_BAR; PG8_MMA(0, 0, At, B0); PG8_MMA(0, 1, At, B1); PG8_BAR; PG8_SCHED;
            PG8_LDA(At, 1, 1); PG8_STAGE(PG8_SB(1, 0), b3, voffB); PG8_STAGE(PG8_SB(1, 1), b3 + hstepB, voffB); PG8_STAGE(PG8_SA(1, 0), a3, voffA);
            PG8_WAIT_V(8); PG8_WAIT_L(0); PG8_BAR; PG8_MMA(1, 0, At, B0); PG8_MMA(1, 1, At, B1); PG8_BAR; PG8_SCHED;
            } else {
            PG8_LDB(B0, 0, 0); PG8_SCHED; PG8_LDA(At, 0, 0); PG8_STAGE(PG8_SA(1, 1), a1 + hstepA, voffA);
            PG8_WAIT_L(8); PG8_BAR; PG8_WAIT_L(0); PG8_MMA(0, 0, At, B0); PG8_BAR; PG8_SCHED;
            PG8_LDB(B1, 0, 1); PG8_STAGE(PG8_SB(0, 0), b2, voffB);
            PG8_BAR; PG8_WAIT_L(0); PG8_MMA(0, 1, At, B1); PG8_BAR;
            PG8_LDA(At, 0, 1); PG8_STAGE(PG8_SA(0, 0), a2, voffA);
            PG8_BAR; PG8_WAIT_L(0); PG8_MMA(1, 0, At, B0); PG8_BAR; PG8_SCHED;
            PG8_STAGE(PG8_SB(0, 1), b2 + hstepB, voffB);
            PG8_WAIT_V(6); PG8_BAR; PG8_MMA(1, 1, At, B1); PG8_BAR;
            PG8_LDB(B0, 1, 0); PG8_SCHED; PG8_LDA(At, 1, 0); PG8_STAGE(PG8_SA(0, 1), a2 + hstepA, voffA);
            PG8_WAIT_L(8); PG8_BAR; PG8_WAIT_L(0); PG8_MMA(0, 0, At, B0); PG8_BAR; PG8_SCHED;
            PG8_LDB(B1, 1, 1); PG8_STAGE(PG8_SB(1, 0), b3, voffB);
            PG8_BAR; PG8_WAIT_L(0); PG8_MMA(0, 1, At, B1); PG8_BAR;
            PG8_LDA(At, 1, 1); PG8_STAGE(PG8_SA(1, 0), a3, voffA);
            PG8_BAR; PG8_WAIT_L(0); PG8_MMA(1, 0, At, B0); PG8_BAR; PG8_SCHED;
            PG8_STAGE(PG8_SB(1, 1), b3 + hstepB, voffB);
            PG8_WAIT_V(6); PG8_BAR; PG8_MMA(1, 1, At, B1); PG8_BAR;
            }
        }
        if constexpr (ALIGN_EPI) { if (wr == 0) PG8_BAR; }
        if constexpr (!Epi::AFTER_DRAIN) { E(acc, cur, wr, wc, fr, fq); S.done(cur); }
        if (!has_next) break;
        if (!E.keep(cur)) {
#pragma unroll
        for (int a = 0; a < 2; ++a)
#pragma unroll
            for (int b = 0; b < 2; ++b)
#pragma unroll
                for (int m = 0; m < 4; ++m)
#pragma unroll
                    for (int n = 0; n < 2; ++n) acc[a][b][m][n] = (f32x4){0.f, 0.f, 0.f, 0.f};
        }
        cur = nxt; cA = nA; cB = nB; ++ui;
        if constexpr (ALIGN_EPI) { if (wr == 1) PG8_BAR; }
    }
    PG8_WAIT_V(0);
    if constexpr (!ALIGN_EPI) { if (wr == 0) PG8_BAR; }
    PG8_BAR;
    if constexpr (Epi::AFTER_DRAIN) { E.fused(acc, cur, wr, wc, fr, fq, lds, wid, lane); S.done(cur); }
#undef PG8_SA
#undef PG8_SB
#undef PG8_STAGE
#undef PG8_LDA
#undef PG8_LDB
#undef PG8_MMA
#undef PG8_WAIT_V
#undef PG8_WAIT_L
#undef PG8_BAR
#undef PG8_SCHED
}
}

#define GAS __attribute__((address_space(1)))
#define LAS __attribute__((address_space(3)))
typedef unsigned short bf16;
typedef unsigned v4u __attribute__((ext_vector_type(4)));
typedef float f32x4 __attribute__((ext_vector_type(4)));
typedef short bf16x8 __attribute__((ext_vector_type(8)));
typedef GAS unsigned gu32;
typedef GAS unsigned long long gu64;
#define RLX_AGENT __ATOMIC_RELAXED, __HIP_MEMORY_SCOPE_AGENT
#define LDS_WAIT() asm volatile("s_waitcnt lgkmcnt(0)" ::: "memory")
#define VM_WAIT() asm volatile("s_waitcnt vmcnt(0)" ::: "memory")
__device__ __forceinline__ unsigned long long rt() { return __builtin_amdgcn_s_memrealtime(); }
__device__ __forceinline__ unsigned f2bf(float f) { unsigned u = __builtin_bit_cast(unsigned, f); return (u + 0x7fffu + ((u >> 16) & 1u)) >> 16; }
__device__ __forceinline__ unsigned pk2(float lo, float hi) { return f2bf(lo) | (f2bf(hi) << 16); }
#define XB_TMO      128
#define XB_XCNT(j)  (256  + 64 * (j))
#define XB_XSUB(j)  (1280 + 64 * (j))
#define XB_XGEN(j)  (2304 + 64 * (j))
#define XB_TOP      3328
#define XB_TOPGEN   3392
#define XCD_BAR_WORDS 3456
#define XB_SPIN_CAP (1u << 18)

__device__ __forceinline__ unsigned xb_ld(unsigned* p)              { return __hip_atomic_load(p, __ATOMIC_RELAXED, __HIP_MEMORY_SCOPE_AGENT); }
__device__ __forceinline__ unsigned xb_add(unsigned* p, unsigned v) { return __hip_atomic_fetch_add(p, v, __ATOMIC_RELAXED, __HIP_MEMORY_SCOPE_AGENT); }
__device__ __forceinline__ unsigned xb_xcc_id() { return (unsigned)__builtin_amdgcn_s_getreg((3 << 11) | 20) & 0xFu; }
#define XB_SPIN(cond, bar) do { unsigned _sp = 0; while (cond) { __builtin_amdgcn_s_sleep(1); \
    if ((++_sp & 255u) == 0u) { if (xb_ld(&(bar)[XB_TMO])) break; if (_sp > XB_SPIN_CAP) { atomicAdd(&(bar)[XB_TMO], 1u); break; } } } } while (0)

struct XcdBarrier {
    unsigned* bar; unsigned x;
    volatile LAS unsigned* st;
};

__device__ __forceinline__ XcdBarrier xcd_barrier_post(unsigned* bar, volatile LAS unsigned* st) {
    XcdBarrier b; b.bar = bar; b.x = xb_xcc_id(); b.st = st;
    if (threadIdx.x == 0) (void)xb_add(&bar[XB_XCNT(b.x)], 1u);
    return b;
}
__device__ __forceinline__ void xcd_barrier_complete(unsigned* bar, unsigned x, unsigned& nloc, unsigned& nx) {
    const unsigned G = gridDim.x * gridDim.y * gridDim.z;
    unsigned sum, cnt, mine, sp = 0u;
    for (;;) {
        sum = 0u; cnt = 0u; mine = 0u;
#pragma unroll
        for (unsigned j = 0; j < 16; ++j) { const unsigned c = xb_ld(&bar[XB_XCNT(j)]); sum += c; cnt += (c > 0u) ? 1u : 0u; mine = (j == x) ? c : mine; }
        if (sum == G) break;
        __builtin_amdgcn_s_sleep(1);
        if ((++sp & 255u) == 0u) { if (xb_ld(&bar[XB_TMO])) break; if (sp > XB_SPIN_CAP) { atomicAdd(&bar[XB_TMO], 1u); break; } }
    }
    nloc = mine > 0u ? mine : 1u; nx = cnt > 0u ? cnt : 1u;
}

__device__ __forceinline__ void xcd_barrier(const XcdBarrier& b) {
    asm volatile("s_waitcnt vmcnt(0)" ::: "memory");
    __syncthreads();
    if (threadIdx.x == 0) {
        unsigned* bar = b.bar;
        __builtin_amdgcn_s_waitcnt(0);
        unsigned nloc = b.st[0], nx = b.st[1];
        if (nloc == 0u) { xcd_barrier_complete(bar, b.x, nloc, nx); b.st[0] = nloc; b.st[1] = nx; }
        const unsigned old = xb_add(&bar[XB_XSUB(b.x)], 1u);
        const unsigned gen = old / nloc;
        if (old + 1u == (gen + 1u) * nloc) {
            __builtin_amdgcn_fence(__ATOMIC_RELEASE, "agent");
            asm volatile("s_waitcnt vmcnt(0)" ::: "memory");
            const unsigned og = xb_add(&bar[XB_TOP], 1u);
            const unsigned tg = og / nx;
            if (og + 1u == (tg + 1u) * nx) xb_add(&bar[XB_TOPGEN], 1u);
            else XB_SPIN(xb_ld(&bar[XB_TOPGEN]) == tg, bar);
            __builtin_amdgcn_fence(__ATOMIC_ACQUIRE, "agent");
            xb_add(&bar[XB_XGEN(b.x)], 1u);
            asm volatile("s_waitcnt vmcnt(0)" ::: "memory");
        } else {
            XB_SPIN(xb_ld(&bar[XB_XGEN(b.x)]) == gen, bar);
            __builtin_amdgcn_fence(__ATOMIC_ACQUIRE, "agent");
            asm volatile("s_waitcnt vmcnt(0)" ::: "memory");
        }
    }
    __syncthreads();
}

constexpr int NB = 16, T = 2048, NT = NB * T, D = 1024, FF = 2816, NMEM = 256;
constexpr float EPS = 1e-6f;
constexpr int NWAVES = 8;
constexpr float LOG2E = 1.4426950408889634f;

namespace pg8 {
__device__ __forceinline__ u32x4 pack8(const f32x4 v0, const f32x4 v1) {
    u32x4 w; w.x = cvt_pk_bf16(v0[0], v0[1]); w.y = cvt_pk_bf16(v0[2], v0[3]); w.z = cvt_pk_bf16(v1[0], v1[1]); w.w = cvt_pk_bf16(v1[2], v1[3]); return w;
}
__device__ __forceinline__ float sigmoidf_(float x) { return __builtin_amdgcn_rcpf(1.0f + __builtin_amdgcn_exp2f(-1.4426950408889634f * x)); }
__device__ __forceinline__ float bf_lo(unsigned w) { return __builtin_bit_cast(float, w << 16); }
__device__ __forceinline__ float bf_hi(unsigned w) { return __builtin_bit_cast(float, w & 0xffff0000u); }

#define EPI_DEFAULTS \
    __device__ __forceinline__ size_t koff(const Unit&) const { return 0; } \
    __device__ __forceinline__ bool keep(const Unit&) const { return false; } \
    __device__ __forceinline__ void mid(f32x4 (&)[2][2][4][2], const Unit&, int, int, int, int, int) const {}
struct EpiSplit {
    EPI_DEFAULTS
    static constexpr bool PERM = true, AFTER_DRAIN = false, HAS_MID = false;
    bf16_t* O0; int ld0; int nt0; bf16_t* O1; int ld1; float s0, s1;
    __device__ __forceinline__ void operator()(const f32x4 (&acc)[2][2][4][2], const Unit& u, int wr, int wc, int fr, int fq) const {
        const bool first = u.pn < nt0;
        bf16_t* base = first ? O0 : O1; const int ld = first ? ld0 : ld1; const float sc = first ? s0 : s1;
        const int colt = (first ? u.pn : u.pn - nt0) * BM;
        const int row0 = u.pm * BM + wr * 64 + fr, col0 = colt + wc * 32 + 8 * fq;
#pragma unroll
        for (int ai = 0; ai < 2; ++ai)
#pragma unroll
            for (int m = 0; m < 4; ++m) { bf16_t* rowp = base + (size_t)(row0 + ai * HALF + m * 16) * ld + col0;
#pragma unroll
                for (int bj = 0; bj < 2; ++bj) *(u32x4*)(rowp + bj * HALF) = pack8(acc[ai][bj][m][0] * sc, acc[ai][bj][m][1] * sc); }
    }
};
struct EpiSwiglu {
    EPI_DEFAULTS
    static constexpr bool PERM = true, AFTER_DRAIN = false, HAS_MID = false;
    bf16_t* O; int ldc;
    __device__ __forceinline__ void operator()(const f32x4 (&acc)[2][2][4][2], const Unit& u, int wr, int wc, int fr, int fq) const {
        const int row0 = u.pm * BM + wr * 64 + fr, col0 = u.pn * HALF + wc * 32 + 8 * fq;
#pragma unroll
        for (int ai = 0; ai < 2; ++ai)
#pragma unroll
            for (int m = 0; m < 4; ++m) {
                f32x4 h[2];
#pragma unroll
                for (int n = 0; n < 2; ++n)
#pragma unroll
                    for (int j = 0; j < 4; ++j) { const float g = acc[ai][0][m][n][j], up = acc[ai][1][m][n][j]; h[n][j] = g * sigmoidf_(g) * up; }
                *(u32x4*)(O + (size_t)(row0 + ai * HALF + m * 16) * ldc + col0) = pack8(h[0], h[1]);
            }
    }
};
struct EpiGates {
    EPI_DEFAULTS
    static constexpr bool PERM = true, AFTER_DRAIN = false, HAS_MID = false;
    bf16_t* O; int ldc;
    __device__ __forceinline__ void operator()(const f32x4 (&acc)[2][2][4][2], const Unit& u, int wr, int wc, int fr, int fq) const {
        const int row0 = u.pm * BM + wr * 64 + fr, col0 = u.pn * BM + wc * 32 + 8 * fq;
#pragma unroll
        for (int ai = 0; ai < 2; ++ai)
#pragma unroll
            for (int m = 0; m < 4; ++m) { bf16_t* rowp = O + (size_t)(row0 + ai * HALF + m * 16) * ldc + col0;
#pragma unroll
                for (int bj = 0; bj < 2; ++bj) { f32x4 a, b;
#pragma unroll
                    for (int j = 0; j < 4; ++j) { a[j] = sigmoidf_(acc[ai][bj][m][0][j]); b[j] = sigmoidf_(acc[ai][bj][m][1][j]); }
                    *(u32x4*)(rowp + bj * HALF) = pack8(a, b); } }
    }
};
struct EpiWinA {
    EPI_DEFAULTS
    static constexpr bool PERM = true, AFTER_DRAIN = false, HAS_MID = false;
    bf16_t* CQ; bf16_t* CKV; float* KW; bf16_t* U; bf16_t* QM; const float* kvg; float qm_scale; PG8_LAS float* red;
    __device__ __forceinline__ void operator()(const f32x4 (&acc)[2][2][4][2], const Unit& u, int wr, int wc, int fr, int fq) const {
        const int row0 = u.pm * BM + wr * 64 + fr; const int cw = wc * 32 + 8 * fq;
        const int pn = u.pn;
        if (pn <= 1) {
#pragma unroll
            for (int ai = 0; ai < 2; ++ai)
#pragma unroll
                for (int m = 0; m < 4; ++m) { float s = 0.f;
#pragma unroll
                    for (int bj = 0; bj < 2; ++bj)
#pragma unroll
                        for (int n = 0; n < 2; ++n) { const f32x4 x = acc[ai][bj][m][n]; s += (x[0] * x[0] + x[1] * x[1]) + (x[2] * x[2] + x[3] * x[3]); }
                    s += __shfl_xor(s, 16); s += __shfl_xor(s, 32);
                    if (fq == 0) red[(ai * HALF + wr * 64 + m * 16 + fr) * 4 + wc] = s; }
            asm volatile("s_waitcnt lgkmcnt(0)" ::: "memory"); __builtin_amdgcn_s_barrier(); asm volatile("" ::: "memory");
            bf16_t* O = pn == 0 ? CQ : CKV;
            f32x4 gv[2][2];
#pragma unroll
            for (int bj = 0; bj < 2; ++bj)
#pragma unroll
                for (int n = 0; n < 2; ++n) gv[bj][n] = pn == 0 ? (f32x4){1.f, 1.f, 1.f, 1.f} : *(const f32x4*)(kvg + bj * HALF + cw + 4 * n);
#pragma unroll
            for (int ai = 0; ai < 2; ++ai)
#pragma unroll
                for (int m = 0; m < 4; ++m) { const int r = ai * HALF + wr * 64 + m * 16 + fr;
                    const f32x4 p = *(const PG8_LAS f32x4*)(red + r * 4);
                    const float rstd = __builtin_amdgcn_rsqf(((p[0] + p[1]) + (p[2] + p[3])) * (1.0f / 256.0f) + 1e-6f);
                    bf16_t* rowp = O + (size_t)(row0 + ai * HALF + m * 16) * 256 + cw;
#pragma unroll
                    for (int bj = 0; bj < 2; ++bj) *(u32x4*)(rowp + bj * HALF) = pack8(acc[ai][bj][m][0] * rstd * gv[bj][0], acc[ai][bj][m][1] * rstd * gv[bj][1]); }
        } else if (pn == 2) {
#pragma unroll
            for (int ai = 0; ai < 2; ++ai)
#pragma unroll
                for (int m = 0; m < 4; ++m) { float* rowp = KW + (size_t)(row0 + ai * HALF + m * 16) * 128 + cw;
                    *(f32x4*)(rowp) = acc[ai][0][m][0]; *(f32x4*)(rowp + 4) = acc[ai][0][m][1]; }
        } else if (pn <= 6) {
            const int col0 = (pn - 3) * HALF + cw;
#pragma unroll
            for (int ai = 0; ai < 2; ++ai)
#pragma unroll
                for (int m = 0; m < 4; ++m) { f32x4 h[2];
#pragma unroll
                    for (int n = 0; n < 2; ++n)
#pragma unroll
                        for (int j = 0; j < 4; ++j) h[n][j] = acc[ai][0][m][n][j] * sigmoidf_(acc[ai][1][m][n][j]);
                    *(u32x4*)(U + (size_t)(row0 + ai * HALF + m * 16) * 512 + col0) = pack8(h[0], h[1]); }
        } else {
            const int col0 = (pn - 7) * BM + cw;
#pragma unroll
            for (int ai = 0; ai < 2; ++ai)
#pragma unroll
                for (int m = 0; m < 4; ++m) { bf16_t* rowp = QM + (size_t)(row0 + ai * HALF + m * 16) * 512 + col0;
#pragma unroll
                    for (int bj = 0; bj < 2; ++bj) *(u32x4*)(rowp + bj * HALF) = pack8(acc[ai][bj][m][0] * qm_scale, acc[ai][bj][m][1] * qm_scale); }
        }
    }
};
struct EpiMerge {
    static constexpr bool PERM = true, AFTER_DRAIN = false, HAS_MID = false;
    const bf16_t* G; bf16_t* O;
    __device__ __forceinline__ size_t koff(const Unit& u) const { return (size_t)u.seg * 1024; }
    __device__ __forceinline__ bool keep(const Unit& u) const { return u.seg < 2; }
    __device__ __forceinline__ void mid(f32x4 (&)[2][2][4][2], const Unit&, int, int, int, int, int) const {}
    __device__ __forceinline__ void operator()(f32x4 (&acc)[2][2][4][2], const Unit& u, int wr, int wc, int fr, int fq) const {
        const int row0 = u.pm * BM + wr * 64 + fr, col0 = u.pn * BM + wc * 32 + 8 * fq;
        const int from = u.seg; const bool last = u.seg == 2;
#pragma unroll
        for (int ai = 0; ai < 2; ++ai)
#pragma unroll
            for (int m = 0; m < 4; ++m) { const bf16_t* rowp = G + (size_t)(row0 + ai * HALF + m * 16) * 3072 + col0; bf16_t* orow = O + (size_t)(row0 + ai * HALF + m * 16) * 1024 + col0;
#pragma unroll
                for (int bj = 0; bj < 2; ++bj) {
                    const u32x4 gf = *(const u32x4*)(rowp + from * 1024 + bj * HALF);
                    u32x4 gt = (u32x4){0x3f803f80u, 0x3f803f80u, 0x3f803f80u, 0x3f803f80u};
                    if (!last) gt = *(const u32x4*)(rowp + (from + 1) * 1024 + bj * HALF);
#pragma unroll
                    for (int q = 0; q < 4; ++q) {
                        const float r0 = bf_lo(gf[q]) * __builtin_amdgcn_rcpf(fmaxf(bf_lo(gt[q]), 1e-30f)), r1 = bf_hi(gf[q]) * __builtin_amdgcn_rcpf(fmaxf(bf_hi(gt[q]), 1e-30f));
                        acc[ai][bj][m][q >> 1][(q & 1) * 2] *= r0; acc[ai][bj][m][q >> 1][(q & 1) * 2 + 1] *= r1; }
                    if (last) *(u32x4*)(orow + bj * HALF) = pack8(acc[ai][bj][m][0], acc[ai][bj][m][1]); }
                asm volatile("" : "+v"(acc[ai][0][m][0]), "+v"(acc[ai][0][m][1]), "+v"(acc[ai][1][m][0]), "+v"(acc[ai][1][m][1]));
                if (m & 1) asm volatile("" ::: "memory"); }
    }
};
struct MergeOrder {
    StaticOrder base;
    __device__ bool next(int i, Unit& u) const { if (!base.next(i / 3, u)) return false; u.seg = i % 3; return true; }
    __device__ __forceinline__ void a_ready(const Unit&) const {}
    __device__ __forceinline__ void done(const Unit&) const {}
};
}

constexpr size_t MiB = 1u << 20;
constexpr size_t WS_CTL = 0, CTL_ZERO_BYTES = 1 * MiB;
constexpr size_t WS_WGU1 = 1 * MiB;
constexpr size_t WS_WDN1 = 12 * MiB;
constexpr size_t WS_WIN = 18 * MiB;
constexpr size_t WS_WQ = 29 * MiB;
constexpr size_t WS_WKV = WS_WQ + 512 * 1024;
constexpr size_t WS_WCAT = 30 * MiB;
constexpr size_t WS_WOUT = 33 * MiB;
constexpr size_t WS_WMK = 35 * MiB, WS_WMV = 36 * MiB;
constexpr size_t WS_WGU2 = 37 * MiB, WS_WDN2 = 48 * MiB;
constexpr size_t WS_H = 54 * MiB;
constexpr size_t WS_Y = 118 * MiB;
constexpr size_t WS_BIG = 182 * MiB;
constexpr size_t WS_CQ = WS_BIG, WS_CKV = WS_BIG + 16 * MiB, WS_KW = WS_BIG + 32 * MiB, WS_Q = WS_BIG + 48 * MiB, WS_KP = WS_BIG + 80 * MiB, WS_VP = WS_BIG + 112 * MiB,
                 WS_QIDX = WS_BIG + 144 * MiB, WS_KIDX = WS_BIG + 160 * MiB, WS_WIDX = WS_BIG + 164 * MiB;
constexpr size_t WS_ACT = 374 * MiB;
constexpr size_t WS_MEMN = 470 * MiB, WS_MK = 478 * MiB, WS_MVT = 482 * MiB, WS_END = 486 * MiB;
static_assert(WS_WGU1 + (size_t)5632 * 1024 * 2 <= WS_WDN1 && WS_WDN1 + (size_t)1024 * 2816 * 2 <= WS_WIN && WS_WIN + (size_t)5376 * 1024 * 2 <= WS_WQ && WS_WKV + (size_t)1024 * 256 * 2 <= WS_WCAT &&
              WS_WCAT + (size_t)1024 * 1536 * 2 <= WS_WOUT && WS_WOUT + 2 * MiB <= WS_WMK && WS_WGU2 + 11 * MiB <= WS_WDN2 && WS_WDN2 + (size_t)1024 * 2816 * 2 <= WS_H, "weights map");
static_assert(WS_BIG + (size_t)NT * 2816 * 2 <= WS_ACT && WS_BIG + (size_t)NT * 3072 * 2 <= WS_ACT && WS_ACT + (size_t)NT * 1536 * 2 <= WS_MEMN && WS_WIDX + (size_t)NT * 16 <= WS_ACT, "act map");
constexpr int CW_BAR = 4096;

constexpr int RING_BYTES = 131072;
constexpr int LDSCTL_OFF = RING_BYTES, MISC_OFF = LDSCTL_OFF + 320, RED_OFF = RING_BYTES + 1024;
constexpr int LDS_BYTES = 147456;

struct Frame {
    LAS unsigned char* lds;
    int tid, lane, wave, G;
    const float* in[31]; float* out; unsigned char* ws;
};

__device__ __forceinline__ float wave_sum(float v) {
#pragma unroll
    for (int o = 1; o < 64; o <<= 1) v += __shfl_xor(v, o);
    return v;
}
__device__ __forceinline__ float wave_max(float v) {
#pragma unroll
    for (int o = 1; o < 64; o <<= 1) v = fmaxf(v, __shfl_xor(v, o));
    return v;
}
__device__ __forceinline__ float bf2f(unsigned short b) { return __builtin_bit_cast(float, (unsigned)b << 16); }

__device__ __forceinline__ int map_col(int kind, int off, int np) {
    if (kind == 0) return off + np;
    const int tile = np >> 8, i = np & 255;
    if (kind == 1) return i < 128 ? tile * 128 + i : 2816 + tile * 128 + (i - 128);
    if (tile <= 1) return np;
    if (tile == 2) return i < 68 ? 512 + i : -1;
    if (tile <= 6) { const int j = tile - 3; return i < 128 ? 580 + j * 128 + i : 1092 + j * 128 + (i - 128); }
    return 1604 + (tile - 7) * 256 + i;
}
__device__ __forceinline__ void transpose_item(const float* W, int srcN, bf16* WT, int ldo, int koff, int nblk, int kind, int off, const float* rowscale, float scale, LAS float* scr, int item, int lane) {
    const int kb = item / nblk, nb = item % nblk, k0 = 64 * kb, n0 = 32 * nb;
    const int col = map_col(kind, off, n0 + (lane & 31));
#pragma unroll 8
    for (int i = 0; i < 32; ++i) { const int kk = 2 * i + (lane >> 5);
        float v = 0.f; if (col >= 0) { v = W[(size_t)(k0 + kk) * srcN + col] * scale; if (rowscale) v *= rowscale[k0 + kk]; }
        scr[kk * 33 + (lane & 31)] = v; }
    LDS_WAIT(); asm volatile("" ::: "memory");
    const int c = lane & 7;
#pragma unroll
    for (int j = 0; j < 4; ++j) { const int n = (lane >> 3) + 8 * j; const LAS float* s = scr + (8 * c) * 33 + n;
        v4u o; o.x = pk2(s[0 * 33], s[1 * 33]); o.y = pk2(s[2 * 33], s[3 * 33]); o.z = pk2(s[4 * 33], s[5 * 33]); o.w = pk2(s[6 * 33], s[7 * 33]);
        *(v4u*)(WT + (size_t)(n0 + n) * ldo + koff + k0 + 8 * c) = o; }
    LDS_WAIT(); asm volatile("" ::: "memory");
}
__device__ __forceinline__ void rms_row_to_bf16(const float* xrow, bf16* orow, int lane) {
    const f32x4* xr = (const f32x4*)xrow + lane;
    f32x4 v[4]; float s = 0.f;
#pragma unroll
    for (int j = 0; j < 4; ++j) { v[j] = xr[64 * j]; s += (v[j].x * v[j].x + v[j].y * v[j].y) + (v[j].z * v[j].z + v[j].w * v[j].w); }
    const float rstd = 1.0f / sqrtf(wave_sum(s) * (1.f / 1024.f) + EPS);
    unsigned long long* o8 = (unsigned long long*)orow + lane;
#pragma unroll
    for (int j = 0; j < 4; ++j) o8[64 * j] = (unsigned long long)pk2(v[j].x * rstd, v[j].y * rstd) | ((unsigned long long)pk2(v[j].z * rstd, v[j].w * rstd) << 32);
}
struct TrJob { int src; int srcN; size_t dst; int ldo, koff, K, nout, kind, off, rs; float scale; };
__device__ __forceinline__ void p0_prologue(Frame& F) {
    { int t_ = threadIdx.x; asm volatile("" : "+v"(t_)); F.tid = t_; F.lane = t_ & 63; F.wave = __builtin_amdgcn_readfirstlane(t_ >> 6); }
    LAS float* scr = (LAS float*)(F.lds + F.wave * 16384);
    const int gw = blockIdx.x * NWAVES + F.wave, NGW = F.G * NWAVES;
    constexpr int NJ = 16;
    constexpr TrJob jobs[NJ] = {
        {4, 5632, WS_WGU1, 1024, 0, 1024, 5632, 1, 0, 2, 1.f},
        {5, 1024, WS_WDN1, 2816, 0, 2816, 1024, 0, 0, -1, 1.f},
        {8, 5188, WS_WIN, 1024, 0, 1024, 2304, 2, 0, 6, 1.f},
        {8, 5188, WS_WIN + (size_t)2304 * 1024 * 2, 1024, 0, 1024, 3072, 0, 2116, 6, 1.f},
        {11, 512, WS_WQ, 256, 0, 256, 512, 0, 0, 9, 0.125f},
        {14, 256, WS_WQ + (size_t)512 * 256 * 2, 256, 0, 256, 256, 0, 0, 9, 0.125f},
        {12, 512, WS_WKV, 256, 0, 256, 512, 0, 0, -1, 1.f},
        {13, 512, WS_WKV + (size_t)512 * 256 * 2, 256, 0, 256, 512, 0, 0, -1, 1.f},
        {17, 1024, WS_WCAT, 1536, 0, 512, 1024, 0, 0, -1, 1.f},
        {22, 1024, WS_WCAT, 1536, 512, 512, 1024, 0, 0, -1, 1.f},
        {25, 1024, WS_WCAT, 1536, 1024, 512, 1024, 0, 0, -1, 1.f},
        {26, 1024, WS_WOUT, 1024, 0, 1024, 1024, 0, 0, -1, 1.f},
        {24, 1024, WS_WMK, 1024, 0, 1024, 512, 0, 0, 23, 1.f},
        {24, 1024, WS_WMV, 1024, 0, 1024, 512, 0, 512, 23, 1.f},
        {29, 5632, WS_WGU2, 1024, 0, 1024, 5632, 1, 0, 27, 1.f},
        {30, 1024, WS_WDN2, 2816, 0, 2816, 1024, 0, 0, -1, 1.f},
    };
    int base = 0;
#pragma unroll
    for (int j = 0; j < NJ; ++j) {
        const TrJob jb = jobs[j];
        const int nblk = jb.nout / 32, nitems = (jb.K / 64) * nblk;
        int first = (gw - (base % NGW) + NGW) % NGW;
        for (int it = first; it < nitems; it += NGW)
            transpose_item(F.in[jb.src], jb.srcN, (bf16*)(F.ws + jb.dst), jb.ldo, jb.koff, nblk, jb.kind, jb.off, jb.rs >= 0 ? F.in[jb.rs] : nullptr, jb.scale, scr, it, F.lane);
        base += nitems;
    }
    bf16* H = (bf16*)(F.ws + WS_H); bf16* MEMN = (bf16*)(F.ws + WS_MEMN);
    for (int m = gw; m < NT; m += NGW) rms_row_to_bf16(F.in[0] + (size_t)m * D, H + (size_t)m * D, F.lane);
    for (int m = gw; m < NB * NMEM; m += NGW) rms_row_to_bf16(F.in[1] + (size_t)m * D, MEMN + (size_t)m * D, F.lane);
}

__device__ __forceinline__ void ew_phase(Frame& F, const bf16* Y, const float* xin, const float* gain, float coef, float* xout, bf16* hout) {
    { int t_ = threadIdx.x; asm volatile("" : "+v"(t_)); F.tid = t_; F.lane = t_ & 63; F.wave = __builtin_amdgcn_readfirstlane(t_ >> 6); }
    const int gw = blockIdx.x * NWAVES + F.wave, NGW = F.G * NWAVES, lane = F.lane;
    f32x4 gv[4];
#pragma unroll
    for (int j = 0; j < 4; ++j) gv[j] = ((const f32x4*)gain)[lane + 64 * j] * coef;
    for (int m = gw; m < NT; m += NGW) {
        const unsigned long long* yr = (const unsigned long long*)(Y + (size_t)m * D) + lane;
        const f32x4* xr = (const f32x4*)(xin + (size_t)m * D) + lane;
        f32x4 yv[4], xv[4]; float s = 0.f;
#pragma unroll
        for (int j = 0; j < 4; ++j) { const unsigned long long w = yr[64 * j]; xv[j] = xr[64 * j];
            yv[j].x = bf2f((unsigned short)w); yv[j].y = bf2f((unsigned short)(w >> 16)); yv[j].z = bf2f((unsigned short)(w >> 32)); yv[j].w = bf2f((unsigned short)(w >> 48));
            s += (yv[j].x * yv[j].x + yv[j].y * yv[j].y) + (yv[j].z * yv[j].z + yv[j].w * yv[j].w); }
        const float rstd = 1.0f / sqrtf(wave_sum(s) * (1.f / 1024.f) + EPS);
        float s2 = 0.f;
#pragma unroll
        for (int j = 0; j < 4; ++j) { xv[j] = xv[j] + gv[j] * yv[j] * rstd; s2 += (xv[j].x * xv[j].x + xv[j].y * xv[j].y) + (xv[j].z * xv[j].z + xv[j].w * xv[j].w); }
        f32x4* xo = (f32x4*)(xout + (size_t)m * D) + lane;
#pragma unroll
        for (int j = 0; j < 4; ++j) xo[64 * j] = xv[j];
        if (hout) {
            const float r2 = 1.0f / sqrtf(wave_sum(s2) * (1.f / 1024.f) + EPS);
            unsigned long long* o8 = (unsigned long long*)(hout + (size_t)m * D) + lane;
#pragma unroll
            for (int j = 0; j < 4; ++j) o8[64 * j] = (unsigned long long)pk2(xv[j].x * r2, xv[j].y * r2) | ((unsigned long long)pk2(xv[j].z * r2, xv[j].w * r2) << 32);
        }
    }
}

__device__ __forceinline__ void kidx_phase(Frame& F) {
    { int t_ = threadIdx.x; asm volatile("" : "+v"(t_)); F.tid = t_; F.lane = t_ & 63; F.wave = __builtin_amdgcn_readfirstlane(t_ >> 6); }
    const int gw = blockIdx.x * NWAVES + F.wave, NGW = F.G * NWAVES, lane = F.lane;
    const float* KW = (const float*)(F.ws + WS_KW); bf16* KIDX = (bf16*)(F.ws + WS_KIDX); float* WIDX = (float*)(F.ws + WS_WIDX);
    const float g = F.in[15][lane], b = F.in[16][lane];
    for (int m = gw; m < NT; m += NGW) {
        const float v = KW[(size_t)m * 128 + lane];
        const float mean = wave_sum(v) * (1.f / 64.f); const float xc = v - mean;
        const float var = wave_sum(xc * xc) * (1.f / 64.f);
        KIDX[(size_t)m * 64 + lane] = (bf16)f2bf(xc * (1.0f / sqrtf(var + EPS)) * g + b);
        if (lane < 4) WIDX[(size_t)m * 4 + lane] = KW[(size_t)m * 128 + 64 + lane] * 0.5f;
    }
}

__device__ __forceinline__ void conv_phase(Frame& F) {
    { int t_ = threadIdx.x; asm volatile("" : "+v"(t_)); F.tid = t_; F.lane = t_ & 63; F.wave = __builtin_amdgcn_readfirstlane(t_ >> 6); }
    const int ch = F.tid, lane = F.lane, wave = F.wave;
    const bf16* U = (const bf16*)(F.ws + WS_Y); bf16* ACT = (bf16*)(F.ws + WS_ACT);
    float wv[31];
#pragma unroll
    for (int j = 0; j < 31; ++j) wv[j] = F.in[18][j * 512 + ch];
    const float bias = F.in[19][ch], lg = F.in[20][ch], lb = F.in[21][ch];
    LAS float* red = (LAS float*)F.lds;
    int par = 0;
    for (int unit = blockIdx.x; unit < NT / 128; unit += F.G) {
        const int tok0 = unit * 128, tb = tok0 % T;
        float win[31];
        win[0] = 0.f;
#pragma unroll
        for (int k = 1; k <= 30; ++k) { const int p = tb - 31 + k; win[k] = p >= 0 ? bf2f(U[(size_t)(tok0 - 31 + k) * 512 + ch]) : 0.f; }
#pragma unroll 1
        for (int grp = 0; grp < 8; ++grp) {
            float y[16];
#pragma unroll
            for (int i = 0; i < 16; ++i) {
#pragma unroll
                for (int j = 0; j < 30; ++j) win[j] = win[j + 1];
                win[30] = bf2f(U[(size_t)(tok0 + grp * 16 + i) * 512 + ch]);
                float a = bias;
#pragma unroll
                for (int j = 0; j < 31; ++j) a += wv[j] * win[j];
                y[i] = a;
            }
#pragma unroll
            for (int i = 0; i < 16; ++i) { const float s1 = wave_sum(y[i]), s2 = wave_sum(y[i] * y[i]);
                if (lane == 0) { red[((par * 16 + i) * 8 + wave) * 2] = s1; red[((par * 16 + i) * 8 + wave) * 2 + 1] = s2; } }
            __syncthreads();
#pragma unroll
            for (int i = 0; i < 16; ++i) { float t1 = 0.f, t2 = 0.f;
#pragma unroll
                for (int w = 0; w < 8; ++w) { t1 += red[((par * 16 + i) * 8 + w) * 2]; t2 += red[((par * 16 + i) * 8 + w) * 2 + 1]; }
                const float mean = t1 * (1.f / 512.f), var = fmaxf(t2 * (1.f / 512.f) - mean * mean, 0.f);
                float v = (y[i] - mean) * (1.0f / sqrtf(var + EPS)) * lg + lb;
                v = v * pg8::sigmoidf_(v);
                ACT[(size_t)(tok0 + grp * 16 + i) * 1536 + 512 + ch] = (bf16)f2bf(v); }
            par ^= 1;
        }
    }
    __syncthreads();
}

typedef float f32x16 __attribute__((ext_vector_type(16)));
typedef short s16x4 __attribute__((ext_vector_type(4)));
__device__ __forceinline__ void memattn_phase(Frame& F) {
    { int t_ = threadIdx.x; asm volatile("" : "+v"(t_)); F.tid = t_; F.lane = t_ & 63; F.wave = __builtin_amdgcn_readfirstlane(t_ >> 6); }
    const int gw = blockIdx.x * NWAVES + F.wave, NGW = F.G * NWAVES, lane = F.lane, g = lane >> 4, r = lane & 15;
    const bf16* QM = (const bf16*)(F.ws + WS_Y) + (size_t)NT * 512;
    const bf16* MK = (const bf16*)(F.ws + WS_MK);
    const bf16* MVT = (const bf16*)(F.ws + WS_MVT);
    bf16* ACT = (bf16*)(F.ws + WS_ACT);
    for (int tsk = gw; tsk < NB * 4 * (T / 16); tsk += NGW) {
        const int bh = tsk / (T / 16), qc = tsk % (T / 16), b = bh >> 2, h = bh & 3;
        const size_t tok0 = (size_t)b * T + qc * 16;
        bf16x8 qf[4];
#pragma unroll
        for (int ks = 0; ks < 4; ++ks) qf[ks] = *(const bf16x8*)(QM + (tok0 + r) * 512 + h * 128 + 32 * ks + 8 * g);
        f32x4 acc[16];
#pragma unroll
        for (int nt = 0; nt < 16; ++nt) { acc[nt] = (f32x4){0.f, 0.f, 0.f, 0.f};
            const bf16* kp = MK + (size_t)(b * 256 + 16 * nt + r) * 512 + h * 128 + 8 * g;
#pragma unroll
            for (int ks = 0; ks < 4; ++ks) acc[nt] = __builtin_amdgcn_mfma_f32_16x16x32_bf16(*(const bf16x8*)(kp + 32 * ks), qf[ks], acc[nt], 0, 0, 0);
            if ((nt & 3) == 3) asm volatile("" ::: "memory"); }
        float mx = -INFINITY;
#pragma unroll
        for (int nt = 0; nt < 16; ++nt) mx = fmaxf(fmaxf(mx, fmaxf(acc[nt][0], acc[nt][1])), fmaxf(acc[nt][2], acc[nt][3]));
        mx = fmaxf(mx, __shfl_xor(mx, 16)); mx = fmaxf(mx, __shfl_xor(mx, 32));
        float l = 0.f;
#pragma unroll
        for (int nt = 0; nt < 16; ++nt)
#pragma unroll
            for (int j = 0; j < 4; ++j) { acc[nt][j] = __builtin_amdgcn_exp2f(acc[nt][j] - mx); l += acc[nt][j]; }
        l += __shfl_xor(l, 16); l += __shfl_xor(l, 32);
        const float rl = 1.0f / l;
        f32x4 o[8];
#pragma unroll
        for (int dt = 0; dt < 8; ++dt) o[dt] = (f32x4){0.f, 0.f, 0.f, 0.f};
#pragma unroll
        for (int ks = 0; ks < 8; ++ks) {
            const pg8::u32x4 pw = pg8::pack8(acc[2 * ks], acc[2 * ks + 1]);
            const bf16x8 pf = __builtin_bit_cast(bf16x8, pw);
#pragma unroll
            for (int dt = 0; dt < 8; ++dt) {
                const bf16* vp = MVT + (size_t)(h * 128 + 16 * dt + r) * (NB * 256) + b * 256 + 32 * ks + 4 * g;
                const s16x4 v0 = *(const s16x4*)vp, v1 = *(const s16x4*)(vp + 16);
                const bf16x8 vf = (bf16x8){v0[0], v0[1], v0[2], v0[3], v1[0], v1[1], v1[2], v1[3]};
                o[dt] = __builtin_amdgcn_mfma_f32_16x16x32_bf16(vf, pf, o[dt], 0, 0, 0);
            }
            asm volatile("" ::: "memory");
        }
#pragma unroll
        for (int dt = 0; dt < 8; ++dt) {
            const unsigned lo = pk2(o[dt][0] * rl, o[dt][1] * rl), hi = pk2(o[dt][2] * rl, o[dt][3] * rl);
            *(unsigned long long*)(ACT + (tok0 + r) * 1536 + 1024 + h * 128 + 16 * dt + 4 * g) = MK_ZERO_MEM ? 0ull : ((unsigned long long)lo | ((unsigned long long)hi << 32));
        }
    }
}

typedef __bf16 bf16x2_t __attribute__((ext_vector_type(2)));
__device__ __forceinline__ float dot2bf(unsigned a, unsigned b, float c) { return __builtin_amdgcn_fdot2_f32_bf16(__builtin_bit_cast(bf16x2_t, a), __builtin_bit_cast(bf16x2_t, b), c, false); }
constexpr int DSA_S_OFF = 0, DSA_SEL_OFF = 65536, DSA_QP_OFF = 69632;
__device__ __forceinline__ void dsa_phase(Frame& F) {
    { int t_ = threadIdx.x; asm volatile("" : "+v"(t_)); F.tid = t_; F.lane = t_ & 63; F.wave = __builtin_amdgcn_readfirstlane(t_ >> 6); }
    const int lane = F.lane, wave = F.wave, c = lane & 31, hi = lane >> 5;
    const bf16* Q = (const bf16*)(F.ws + WS_Q); const bf16* KP = (const bf16*)(F.ws + WS_KP); const bf16* VP = (const bf16*)(F.ws + WS_VP);
    const bf16* QIDX = (const bf16*)(F.ws + WS_QIDX); const bf16* KIDX = (const bf16*)(F.ws + WS_KIDX); const float* WIDX = (const float*)(F.ws + WS_WIDX);
    bf16* ACT = (bf16*)(F.ws + WS_ACT);
    LAS float* S = (LAS float*)(F.lds + DSA_S_OFF);
    LAS unsigned short* SEL = (LAS unsigned short*)(F.lds + DSA_SEL_OFF) + wave * 256;
    LAS unsigned* QP = (LAS unsigned*)(F.lds + DSA_QP_OFF) + wave * 256;
    LAS float* Sw = S + wave * 2048; LAS float* Pw = Sw;
    for (int i = 0; i * F.G + (int)blockIdx.x < NB * (T / 8); ++i) {
        const int unit = i * F.G + (int)blockIdx.x, b = unit >> 8, qb = ((unit & 255) + 16 * b) & 255;
        const int t0 = qb * 8; const size_t tokb = (size_t)b * T;
        {
            bf16x8 aq[4]; const int qq = c >> 2, hh = c & 3;
#pragma unroll
            for (int ks = 0; ks < 4; ++ks) aq[ks] = *(const bf16x8*)(QIDX + (tokb + t0 + qq) * 256 + hh * 64 + 16 * ks + 8 * hi);
            f32x4 wq[4];
#pragma unroll
            for (int jj = 0; jj < 4; ++jj) wq[jj] = *(const f32x4*)(WIDX + (tokb + t0 + 2 * jj + hi) * 4);
            const int ntiles = (t0 + 8 + 31) >> 5;
            for (int tile = wave; tile < ntiles; tile += NWAVES) {
                const int key = 32 * tile + c;
                f32x16 acc = {};
#pragma unroll
                for (int ks = 0; ks < 4; ++ks) acc = __builtin_amdgcn_mfma_f32_32x32x16_bf16(aq[ks], *(const bf16x8*)(KIDX + (tokb + key) * 64 + 16 * ks + 8 * hi), acc, 0, 0, 0);
#pragma unroll
                for (int jj = 0; jj < 4; ++jj) { float sc = 0.f;
#pragma unroll
                    for (int h = 0; h < 4; ++h) sc += wq[jj][h] * fmaxf(acc[4 * jj + h], 0.f);
                    S[(2 * jj + hi) * 2048 + key] = sc; }
            }
        }
        __syncthreads();
        const int t = t0 + wave; const size_t tok = tokb + t;
        const int nsel = t < 256 ? t + 1 : 256;
        if (t < 256) {
#pragma unroll
            for (int k = 0; k < 4; ++k) SEL[lane + 64 * k] = (unsigned short)(lane + 64 * k);
        } else {
            unsigned u[32];
#pragma unroll
            for (int k = 0; k < 32; ++k) { const int key = lane + 64 * k; const unsigned bits = __builtin_bit_cast(unsigned, Sw[key]);
                const unsigned o = (bits & 0x80000000u) ? ~bits : (bits | 0x80000000u); u[k] = key <= t ? o : 0u; }
            unsigned tau = 0u;
#pragma unroll 1
            for (int bit = 31; bit >= 0; --bit) { const unsigned cand = tau | (1u << bit); int cnt = 0;
#pragma unroll
                for (int k = 0; k < 32; ++k) cnt += __popcll(__ballot(u[k] >= cand));
                if (cnt >= 256) tau = cand; }
            int cgt = 0;
#pragma unroll
            for (int k = 0; k < 32; ++k) cgt += __popcll(__ballot(u[k] > tau));
            const int need = 256 - cgt; int run = 0, base = 0;
            const unsigned long long lt = (1ull << lane) - 1ull;
#pragma unroll
            for (int k = 0; k < 32; ++k) { const int key = lane + 64 * k; const bool valid = key <= t;
                const bool eq = valid && u[k] == tau; const unsigned long long em = __ballot(eq);
                const bool sel = valid && (u[k] > tau || (eq && run + __popcll(em & lt) < need));
                const unsigned long long sm = __ballot(sel);
                if (sel) SEL[base + __popcll(sm & lt)] = (unsigned short)key;
                run += __popcll(em); base += __popcll(sm); }
        }
        *(LAS v4u*)(QP + 4 * lane) = *(const v4u*)(Q + tok * 512 + 8 * lane);
        LDS_WAIT(); asm volatile("" ::: "memory");
        float s[4][8]; int keyi[4];
#pragma unroll
        for (int i2 = 0; i2 < 4; ++i2) { const int slot = lane + 64 * i2; keyi[i2] = slot < nsel ? (int)SEL[slot] : 0;
#pragma unroll
            for (int h = 0; h < 8; ++h) s[i2][h] = 0.f; }
#pragma unroll
        for (int h = 0; h < 8; ++h) {
            float a0 = 0.f, a1 = 0.f, a2 = 0.f, a3 = 0.f;
#pragma unroll
            for (int ch = 0; ch < 8; ++ch) {
                const v4u qv = *(const LAS v4u*)(QP + h * 32 + 4 * ch);
                const v4u k0 = *(const v4u*)(KP + (tokb + keyi[0]) * 512 + h * 64 + 8 * ch), k1 = *(const v4u*)(KP + (tokb + keyi[1]) * 512 + h * 64 + 8 * ch),
                          k2 = *(const v4u*)(KP + (tokb + keyi[2]) * 512 + h * 64 + 8 * ch), k3 = *(const v4u*)(KP + (tokb + keyi[3]) * 512 + h * 64 + 8 * ch);
#pragma unroll
                for (int e = 0; e < 4; ++e) { a0 = dot2bf(qv[e], k0[e], a0); a1 = dot2bf(qv[e], k1[e], a1); a2 = dot2bf(qv[e], k2[e], a2); a3 = dot2bf(qv[e], k3[e], a3); }
            }
            s[0][h] = a0; s[1][h] = a1; s[2][h] = a2; s[3][h] = a3;
        }
        float linv_sel = 0.f;
#pragma unroll
        for (int h = 0; h < 8; ++h) {
            float m = -INFINITY;
#pragma unroll
            for (int i2 = 0; i2 < 4; ++i2) { if (lane + 64 * i2 >= nsel) s[i2][h] = -INFINITY; m = fmaxf(m, s[i2][h]); }
            m = wave_max(m);
            float l = 0.f;
#pragma unroll
            for (int i2 = 0; i2 < 4; ++i2) { s[i2][h] = __builtin_amdgcn_exp2f((s[i2][h] - m) * LOG2E); l += s[i2][h]; }
            l = wave_sum(l);
            if ((lane >> 3) == h) linv_sel = 1.0f / l;
        }
#pragma unroll
        for (int i2 = 0; i2 < 4; ++i2) { const int slot = lane + 64 * i2;
            *(LAS f32x4*)(Pw + slot * 8) = (f32x4){s[i2][0], s[i2][1], s[i2][2], s[i2][3]}; *(LAS f32x4*)(Pw + slot * 8 + 4) = (f32x4){s[i2][4], s[i2][5], s[i2][6], s[i2][7]}; }
        LDS_WAIT(); asm volatile("" ::: "memory");
        float o[8];
#pragma unroll
        for (int j = 0; j < 8; ++j) o[j] = 0.f;
        const int hsel = lane >> 3;
#pragma unroll 4
        for (int slot = 0; slot < nsel; ++slot) {
            const int key = SEL[slot]; const float p = Pw[slot * 8 + hsel];
            const v4u vv = *(const v4u*)(VP + (tokb + key) * 512 + 8 * lane);
#pragma unroll
            for (int e = 0; e < 4; ++e) { o[2 * e] += p * pg8::bf_lo(vv[e]); o[2 * e + 1] += p * pg8::bf_hi(vv[e]); }
        }
        v4u ov; ov.x = pk2(o[0] * linv_sel, o[1] * linv_sel); ov.y = pk2(o[2] * linv_sel, o[3] * linv_sel); ov.z = pk2(o[4] * linv_sel, o[5] * linv_sel); ov.w = pk2(o[6] * linv_sel, o[7] * linv_sel);
        if (MK_ZERO_DSA) ov = (v4u){0u, 0u, 0u, 0u};
        *(v4u*)(ACT + tok * 1536 + 8 * lane) = ov;
        __syncthreads();
    }
}

constexpr int N_PHASES = 14;
struct Args { const float* in[31]; float* out; unsigned char* ws; int ph_lo, ph_hi; };
__global__ void __launch_bounds__(NWAVES * 64, 2) mk_fwd(Args args) {
    extern __shared__ __attribute__((aligned(16))) unsigned char lds[];
    Frame F;
    F.lds = (LAS unsigned char*)lds;
    F.tid = threadIdx.x; F.lane = F.tid & 63; F.wave = __builtin_amdgcn_readfirstlane(F.tid >> 6); F.G = gridDim.x;
#pragma unroll
    for (int i = 0; i < 31; ++i) F.in[i] = args.in[i];
    F.out = args.out; F.ws = args.ws;
    unsigned char* ws = args.ws;
    for (int u = F.tid; u < (LDS_BYTES - LDSCTL_OFF) / 4; u += NWAVES * 64) ((LAS unsigned*)(F.lds + LDSCTL_OFF))[u] = 0u;
    __syncthreads();
#if MK_ONE_LAUNCH
    cooperative_groups::grid_group grid = cooperative_groups::this_grid();
    XcdBarrier bar = xcd_barrier_post((unsigned*)(ws + WS_CTL) + CW_BAR, (volatile LAS unsigned*)(F.lds + MISC_OFF) + 8);
#define SEAM(k) do { if ((k) == 0) grid.sync(); else xcd_barrier(bar); } while (0)
#else
#define SEAM(k) do { } while (0)
#endif
    const int lo = args.ph_lo, hi = args.ph_hi;
#define IN(k) ((((MK_PHMASK) >> (k)) & 1) && lo <= (k) && (k) < hi)
#define BOTH(k) (IN(k) && IN((k) + 1))
    typedef pg8::bf16_t bt;
    bt* H = (bt*)(ws + WS_H); bt* Y = (bt*)(ws + WS_Y); bt* HID = (bt*)(ws + WS_BIG); bt* ACT = (bt*)(ws + WS_ACT);
    float* X1 = F.out;
    const int bid = (int)blockIdx.x;

    if (IN(0)) { p0_prologue(F); if (BOTH(0)) SEAM(0); }
    if (IN(1)) {
        { pg8::Gemm g{H, (const bt*)(ws + WS_WGU1), NT, 5632, 1024, 1024, 1024}; pg8::StaticOrder S; S.init(NT, 5632, F.G, bid); pg8::EpiSwiglu E{HID, FF};
          pg8::gemm_phase<pg8::EpiSwiglu, pg8::StaticOrder, true, true>(F.lds, g, S, E); }
        { pg8::Gemm g{(const bt*)(ws + WS_MEMN), (const bt*)(ws + WS_WMK), NB * NMEM, 512, 1024, 1024, 1024}; pg8::StaticOrder S; S.init(NB * NMEM, 512, F.G, bid);
          pg8::EpiSplit E{(bt*)(ws + WS_MK), 512, 1 << 20, nullptr, 0, 1.f, 1.f}; pg8::gemm_phase<pg8::EpiSplit, pg8::StaticOrder, true, true>(F.lds, g, S, E); }
        { pg8::Gemm g{(const bt*)(ws + WS_WMV), (const bt*)(ws + WS_MEMN), 512, NB * NMEM, 1024, 1024, 1024}; pg8::StaticOrder S; S.init(512, NB * NMEM, F.G, bid);
          pg8::EpiSplit E{(bt*)(ws + WS_MVT), NB * NMEM, 1 << 20, nullptr, 0, 1.f, 1.f}; pg8::gemm_phase<pg8::EpiSplit, pg8::StaticOrder, true, true>(F.lds, g, S, E); }
        if (BOTH(1)) SEAM(1);
    }
    if (IN(2)) {
        pg8::Gemm g{HID, (const bt*)(ws + WS_WDN1), NT, 1024, FF, FF, FF}; pg8::StaticOrder S; S.init(NT, 1024, F.G, bid); pg8::EpiSplit E{Y, 1024, 1 << 20, nullptr, 0, 1.f, 1.f};
        pg8::gemm_phase<pg8::EpiSplit, pg8::StaticOrder, true, true>(F.lds, g, S, E);
        if (BOTH(2)) SEAM(2);
    }
    if (IN(3)) { ew_phase(F, (const bf16*)Y, F.in[0], F.in[3], 0.5f, X1, (bf16*)H); if (BOTH(3)) SEAM(3); }
    if (IN(4)) {
        pg8::Gemm g{H, (const bt*)(ws + WS_WIN), NT, 2304, 1024, 1024, 1024}; pg8::StaticOrder S; S.init(NT, 2304, F.G, bid);
        pg8::EpiWinA E{(bt*)(ws + WS_CQ), (bt*)(ws + WS_CKV), (float*)(ws + WS_KW), Y, Y + (size_t)NT * 512, F.in[10], 0.08838834764831845f * LOG2E, (PG8_LAS float*)(F.lds + RED_OFF)};
        pg8::gemm_phase<pg8::EpiWinA, pg8::StaticOrder, true, true>(F.lds, g, S, E);
        if (BOTH(4)) SEAM(4);
    }
    if (IN(5)) {
        if (MK_P5MASK & 1) { pg8::Gemm g{(const bt*)(ws + WS_CQ), (const bt*)(ws + WS_WQ), NT, 768, 256, 256, 256}; pg8::StaticOrder S; S.init(NT, 768, F.G, bid);
          pg8::EpiSplit E{(bt*)(ws + WS_Q), 512, 2, (bt*)(ws + WS_QIDX), 256, 1.f, 1.f}; pg8::gemm_phase<pg8::EpiSplit, pg8::StaticOrder, true, true>(F.lds, g, S, E); }
        if (MK_P5MASK & 2) { pg8::Gemm g{(const bt*)(ws + WS_CKV), (const bt*)(ws + WS_WKV), NT, 1024, 256, 256, 256}; pg8::StaticOrder S; S.init(NT, 1024, F.G, bid);
          pg8::EpiSplit E{(bt*)(ws + WS_KP), 512, 2, (bt*)(ws + WS_VP), 512, 1.f, 1.f}; pg8::gemm_phase<pg8::EpiSplit, pg8::StaticOrder, true, true>(F.lds, g, S, E); }
        if (MK_P5MASK & 4) kidx_phase(F);
        if (MK_P5MASK & 8) conv_phase(F);
        if (MK_P5MASK & 16) memattn_phase(F);
        if (BOTH(5)) SEAM(5);
    }
    if (IN(6)) { dsa_phase(F); if (BOTH(6)) SEAM(6); }
    if (IN(7)) {
        pg8::Gemm g{H, (const bt*)(ws + WS_WIN) + (size_t)2304 * 1024, NT, 3072, 1024, 1024, 1024}; pg8::StaticOrder S; S.init(NT, 3072, F.G, bid); pg8::EpiGates E{HID, 3072};
        pg8::gemm_phase<pg8::EpiGates, pg8::StaticOrder, true, true>(F.lds, g, S, E);
        if (BOTH(7)) SEAM(7);
    }
    if (IN(8)) {
        pg8::Gemm g{ACT, (const bt*)(ws + WS_WCAT), NT, 1024, 512, 1536, 1536}; pg8::MergeOrder S; S.base.init(NT, 1024, F.G, bid); pg8::EpiMerge E{HID, H};
        pg8::gemm_phase<pg8::EpiMerge, pg8::MergeOrder, true, true>(F.lds, g, S, E);
        if (BOTH(8)) SEAM(8);
    }
    if (IN(9)) {
        pg8::Gemm g{H, (const bt*)(ws + WS_WOUT), NT, 1024, 1024, 1024, 1024}; pg8::StaticOrder S; S.init(NT, 1024, F.G, bid); pg8::EpiSplit E{Y, 1024, 1 << 20, nullptr, 0, 1.f, 1.f};
        pg8::gemm_phase<pg8::EpiSplit, pg8::StaticOrder, true, true>(F.lds, g, S, E);
        if (BOTH(9)) SEAM(9);
    }
    if (IN(10)) { ew_phase(F, (const bf16*)Y, X1, F.in[7], 1.0f, X1, (bf16*)H); if (BOTH(10)) SEAM(10); }
    if (IN(11)) {
        pg8::Gemm g{H, (const bt*)(ws + WS_WGU2), NT, 5632, 1024, 1024, 1024}; pg8::StaticOrder S; S.init(NT, 5632, F.G, bid); pg8::EpiSwiglu E{HID, FF};
        pg8::gemm_phase<pg8::EpiSwiglu, pg8::StaticOrder, true, true>(F.lds, g, S, E);
        if (BOTH(11)) SEAM(11);
    }
    if (IN(12)) {
        pg8::Gemm g{HID, (const bt*)(ws + WS_WDN2), NT, 1024, FF, FF, FF}; pg8::StaticOrder S; S.init(NT, 1024, F.G, bid); pg8::EpiSplit E{Y, 1024, 1 << 20, nullptr, 0, 1.f, 1.f};
        pg8::gemm_phase<pg8::EpiSplit, pg8::StaticOrder, true, true>(F.lds, g, S, E);
        if (BOTH(12)) SEAM(12);
    }
    if (IN(13)) { ew_phase(F, (const bf16*)Y, X1, F.in[28], 0.5f, F.out, nullptr); }
#undef IN
#undef BOTH
}

#if MK_DEBUG
constexpr int DBG_W = 2048;
__device__ __forceinline__ float blk_sum(float v, float* sh) {
    v = wave_sum(v); __syncthreads(); if ((threadIdx.x & 63) == 0) sh[threadIdx.x >> 6] = v; __syncthreads();
    float t = 0.f; for (int i = 0; i < 8; ++i) t += sh[i]; __syncthreads(); return t;
}
__device__ __forceinline__ void dbg_report(unsigned char* ws, int slot, float err2, float ref2) {
    if (threadIdx.x == 0) { const float rel = sqrtf(err2 / fmaxf(ref2, 1e-30f)); atomicMax((unsigned*)ws + DBG_W + slot, __builtin_bit_cast(unsigned, rel)); if (rel > 0.03f) atomicAdd((unsigned*)ws + DBG_W + 8 + slot, 1u); }
}
__device__ __forceinline__ int dbg_row(int i) { return (int)(((unsigned)i * 2654435761u) % (unsigned)NT); }
__global__ void __launch_bounds__(512) dbg_ffn(const float* xin, const float* gpre, const float* wgu, const float* wdn, const unsigned short* Y, unsigned char* ws, int slot) {
    __shared__ float h[1024]; __shared__ float hid[2816]; __shared__ float sh[8];
    const int r = dbg_row(blockIdx.x), tid = threadIdx.x;
    float s = 0.f; for (int k = tid; k < 1024; k += 512) { const float v = xin[(size_t)r * 1024 + k]; s += v * v; }
    s = blk_sum(s, sh); const float rstd = 1.0f / sqrtf(s / 1024.f + 1e-6f);
    for (int k = tid; k < 1024; k += 512) h[k] = xin[(size_t)r * 1024 + k] * rstd * gpre[k];
    __syncthreads();
    for (int j = tid; j < 2816; j += 512) { float g = 0.f, u = 0.f; for (int k = 0; k < 1024; ++k) { g += h[k] * wgu[(size_t)k * 5632 + j]; u += h[k] * wgu[(size_t)k * 5632 + 2816 + j]; }
        hid[j] = g / (1.f + expf(-g)) * u; }
    __syncthreads();
    float e2 = 0.f, r2 = 0.f;
    for (int n = tid; n < 1024; n += 512) { float y = 0.f; for (int j = 0; j < 2816; ++j) y += hid[j] * wdn[(size_t)j * 1024 + n];
        const float d = y - bf2f(Y[(size_t)r * 1024 + n]); e2 += d * d; r2 += y * y; }
    e2 = blk_sum(e2, sh); r2 = blk_sum(r2, sh); dbg_report(ws, slot, e2, r2);
}
__global__ void __launch_bounds__(512) dbg_ew(const float* xin, const unsigned short* Y, const float* gain, float coef, const float* xout, const unsigned short* H, unsigned char* ws, int slot) {
    __shared__ float sh[8];
    const int r = dbg_row(blockIdx.x), tid = threadIdx.x;
    float s = 0.f; for (int k = tid; k < 1024; k += 512) { const float v = bf2f(Y[(size_t)r * 1024 + k]); s += v * v; }
    s = blk_sum(s, sh); const float rstd = 1.0f / sqrtf(s / 1024.f + 1e-6f);
    float xn[2]; float s2 = 0.f; float e2 = 0.f, r2 = 0.f;
    for (int i = 0; i < 2; ++i) { const int k = tid + 512 * i; xn[i] = xin[(size_t)r * 1024 + k] + coef * gain[k] * bf2f(Y[(size_t)r * 1024 + k]) * rstd; s2 += xn[i] * xn[i];
        const float d = xn[i] - xout[(size_t)r * 1024 + k]; e2 += d * d; r2 += xn[i] * xn[i]; }
    s2 = blk_sum(s2, sh); const float r2d = 1.0f / sqrtf(s2 / 1024.f + 1e-6f);
    if (H) for (int i = 0; i < 2; ++i) { const int k = tid + 512 * i; const float hv = xn[i] * r2d; const float d = hv - bf2f(H[(size_t)r * 1024 + k]); e2 += d * d; r2 += hv * hv; }
    e2 = blk_sum(e2, sh); r2 = blk_sum(r2, sh); dbg_report(ws, slot, e2, r2);
}
__global__ void __launch_bounds__(512) dbg_conv(const unsigned short* H, const float* gpre, const float* win, const float* wdw, const float* bdw, const float* lng, const float* lnb, const unsigned short* ACT, unsigned char* ws, int slot) {
    __shared__ float hrow[1024]; __shared__ float sh[8];
    const int t = dbg_row(blockIdx.x), tid = threadIdx.x, tb = t % T;
    float y = bdw[tid];
    for (int j = 0; j < 31; ++j) { const int p = tb - 30 + j; if (p < 0) continue;
        const int s = t - 30 + j;
        __syncthreads();
        for (int k = tid; k < 1024; k += 512) hrow[k] = bf2f(H[(size_t)s * 1024 + k]) * gpre[k];
        __syncthreads();
        float a = 0.f, g = 0.f; for (int k = 0; k < 1024; ++k) { a += hrow[k] * win[(size_t)k * 5188 + 580 + tid]; g += hrow[k] * win[(size_t)k * 5188 + 1092 + tid]; }
        y += wdw[j * 512 + tid] * (a / (1.f + expf(-g))); }
    const float mean = blk_sum(y, sh) / 512.f; const float xc = y - mean; const float var = blk_sum(xc * xc, sh) / 512.f;
    float v = xc / sqrtf(var + 1e-6f) * lng[tid] + lnb[tid]; v = v / (1.f + expf(-v));
    const float d = v - bf2f(ACT[(size_t)t * 1536 + 512 + tid]);
    const float e2 = blk_sum(d * d, sh), r2 = blk_sum(v * v, sh); dbg_report(ws, slot, e2, r2);
}

__global__ void __launch_bounds__(512) dbg_merge(const unsigned short* ACT, const unsigned short* G, const float* wa, const float* wb, const float* wm, const unsigned short* Hm, unsigned char* ws, int slot) {
    __shared__ float arow[1536]; __shared__ float sh[8];
    const int r = dbg_row(blockIdx.x), tid = threadIdx.x;
    for (int k = tid; k < 1536; k += 512) arow[k] = bf2f(ACT[(size_t)r * 1536 + k]);
    __syncthreads();
    float e2 = 0.f, r2 = 0.f;
    for (int n = tid; n < 1024; n += 512) { float ya = 0.f, yb = 0.f, ym = 0.f;
        for (int k = 0; k < 512; ++k) { ya += arow[k] * wa[(size_t)k * 1024 + n]; yb += arow[512 + k] * wb[(size_t)k * 1024 + n]; ym += arow[1024 + k] * wm[(size_t)k * 1024 + n]; }
        const float v = bf2f(G[(size_t)r * 3072 + n]) * ya + bf2f(G[(size_t)r * 3072 + 1024 + n]) * yb + bf2f(G[(size_t)r * 3072 + 2048 + n]) * ym;
        const float d = v - bf2f(Hm[(size_t)r * 1024 + n]); e2 += d * d; r2 += v * v; }
    e2 = blk_sum(e2, sh); r2 = blk_sum(r2, sh); dbg_report(ws, slot, e2, r2);
}
__global__ void __launch_bounds__(512) dbg_gemm(const unsigned short* A, int K, const float* W, const unsigned short* O, unsigned char* ws, int slot) {
    __shared__ float arow[2816]; __shared__ float sh[8];
    const int r = dbg_row(blockIdx.x), tid = threadIdx.x;
    for (int k = tid; k < K; k += 512) arow[k] = bf2f(A[(size_t)r * K + k]);
    __syncthreads();
    float e2 = 0.f, r2 = 0.f;
    for (int n = tid; n < 1024; n += 512) { float y = 0.f; for (int k = 0; k < K; ++k) y += arow[k] * W[(size_t)k * 1024 + n];
        const float d = y - bf2f(O[(size_t)r * 1024 + n]); e2 += d * d; r2 += y * y; }
    e2 = blk_sum(e2, sh); r2 = blk_sum(r2, sh); dbg_report(ws, slot, e2, r2);
}
__global__ void dbg_force(unsigned char* ws, int slot) { if (threadIdx.x == 0 && blockIdx.x == 0) ((unsigned*)ws)[DBG_W + slot] = __builtin_bit_cast(unsigned, 1.0f); }

__global__ void __launch_bounds__(512) dbg_lin(const unsigned short* A, int lda, int K, const float* ascale, const float* W, int ldw, int coff, int N, const unsigned short* O, long o_rs, long o_cs, float oscale, int act, int nrows, unsigned char* ws, int slot) {
    __shared__ float arow[1024]; __shared__ float sh[8];
    const int r = (int)(((unsigned)blockIdx.x * 2654435761u) % (unsigned)nrows), tid = threadIdx.x;
    for (int k = tid; k < K; k += 512) arow[k] = bf2f(A[(size_t)r * lda + k]) * (ascale ? ascale[k] : 1.f);
    __syncthreads();
    float e2 = 0.f, r2 = 0.f;
    for (int n = tid; n < N; n += 512) { float y = 0.f; for (int k = 0; k < K; ++k) y += arow[k] * W[(size_t)k * ldw + coff + n];
        y *= oscale; if (act == 1) y = 1.f / (1.f + expf(-y));
        const float dd = y - bf2f(O[(size_t)r * o_rs + (size_t)n * o_cs]); e2 += dd * dd; r2 += y * y; }
    e2 = blk_sum(e2, sh); r2 = blk_sum(r2, sh); dbg_report(ws, slot, e2, r2);
    if (threadIdx.x == 0 && sqrtf(e2 / fmaxf(r2, 1e-30f)) > 0.03f) atomicAdd((unsigned*)ws + DBG_W + 16 + ((r % T) < 256 ? 0 : 1), 1u);
}
__global__ void __launch_bounds__(512) dbg_rms256(const unsigned short* Hh, const float* gpre, const float* win, int coff, const float* gain, const unsigned short* O, unsigned char* ws, int slot) {
    __shared__ float arow[1024]; __shared__ float sh[8];
    const int r = dbg_row(blockIdx.x), tid = threadIdx.x;
    for (int k = tid; k < 1024; k += 512) arow[k] = bf2f(Hh[(size_t)r * 1024 + k]) * gpre[k];
    __syncthreads();
    float z = 0.f; if (tid < 256) for (int k = 0; k < 1024; ++k) z += arow[k] * win[(size_t)k * 5188 + coff + tid];
    const float ss = blk_sum(z * z, sh); const float rstd = 1.0f / sqrtf(ss / 256.f + 1e-6f);
    float e = 0.f, rr = 0.f; if (tid < 256) { const float v = z * rstd * (gain ? gain[tid] : 1.f); const float dd = v - bf2f(O[(size_t)r * 256 + tid]); e = dd * dd; rr = v * v; }
    e = blk_sum(e, sh); rr = blk_sum(rr, sh); dbg_report(ws, slot, e, rr);
}
__global__ void __launch_bounds__(512) dbg_kidx(const unsigned short* Hh, const float* gpre, const float* win, const float* lg, const float* lb, const unsigned short* KIDX, const float* WIDX, unsigned char* ws, int slot) {
    __shared__ float arow[1024]; __shared__ float sh[8];
    const int r = dbg_row(blockIdx.x), tid = threadIdx.x;
    for (int k = tid; k < 1024; k += 512) arow[k] = bf2f(Hh[(size_t)r * 1024 + k]) * gpre[k];
    __syncthreads();
    float z = 0.f; if (tid < 68) for (int k = 0; k < 1024; ++k) z += arow[k] * win[(size_t)k * 5188 + 512 + tid];
    const float mean = blk_sum(tid < 64 ? z : 0.f, sh) / 64.f; const float xc = tid < 64 ? z - mean : 0.f; const float var = blk_sum(xc * xc, sh) / 64.f;
    float e = 0.f, rr = 0.f;
    if (tid < 64) { const float v = xc / sqrtf(var + 1e-6f) * lg[tid] + lb[tid]; const float dd = v - bf2f(KIDX[(size_t)r * 64 + tid]); e = dd * dd; rr = v * v; }
    else if (tid < 68) { const float v = z * 0.5f; const float dd = v - WIDX[(size_t)r * 4 + tid - 64]; e = dd * dd; rr = v * v; }
    e = blk_sum(e, sh); rr = blk_sum(rr, sh); dbg_report(ws, slot, e, rr);
}
__global__ void __launch_bounds__(512) dbg_memattn(const unsigned short* QM, const unsigned short* MK, const unsigned short* MVT, const unsigned short* ACT, unsigned char* ws, int slot) {
    __shared__ float s[4][256]; __shared__ float sh[8];
    const int tok = dbg_row(blockIdx.x), tid = threadIdx.x, b = tok / T, h = tid >> 7, dcol = tid & 127;
    for (int i = 0; i < 2; ++i) { const int idx = tid + 512 * i, hh = idx >> 8, m = idx & 255; float a = 0.f;
        for (int dd = 0; dd < 128; ++dd) a += bf2f(QM[(size_t)tok * 512 + hh * 128 + dd]) * bf2f(MK[(size_t)(b * 256 + m) * 512 + hh * 128 + dd]);
        s[hh][m] = a; }
    __syncthreads();
    float mx = -INFINITY; for (int m = 0; m < 256; ++m) mx = fmaxf(mx, s[h][m]);
    float l = 0.f, o = 0.f; for (int m = 0; m < 256; ++m) { const float p = exp2f(s[h][m] - mx); l += p; o += p * bf2f(MVT[(size_t)(h * 128 + dcol) * (NB * 256) + b * 256 + m]); }
    o /= l; const float dd = o - bf2f(ACT[(size_t)tok * 1536 + 1024 + tid]);
    const float e = blk_sum(dd * dd, sh), rr = blk_sum(o * o, sh); dbg_report(ws, slot, e, rr);
}
__global__ void __launch_bounds__(512) dbg_dsa(const unsigned short* Q, const unsigned short* KP, const unsigned short* VP, const unsigned short* QIDX, const unsigned short* KIDX, const float* WIDX, const unsigned short* ACT, unsigned char* ws, int slot) {
    __shared__ float sc[2048]; __shared__ unsigned char selflag[2048]; __shared__ float sh[8];
    const int tok = dbg_row(blockIdx.x), tid = threadIdx.x, b = tok / T, t = tok % T; const size_t tokb = (size_t)b * T;
    for (int key = tid; key <= t; key += 512) { float tot = 0.f;
        for (int hh = 0; hh < 4; ++hh) { float a = 0.f; for (int dd = 0; dd < 64; ++dd) a += bf2f(QIDX[(size_t)tok * 256 + hh * 64 + dd]) * bf2f(KIDX[(tokb + key) * 64 + dd]); tot += WIDX[(size_t)tok * 4 + hh] * fmaxf(a, 0.f); }
        sc[key] = tot; }
    __syncthreads();
    for (int key = tid; key <= t; key += 512) { int rank = 0; const float v = sc[key]; for (int k2 = 0; k2 <= t; ++k2) { const float w = sc[k2]; rank += (w > v || (w == v && k2 < key)) ? 1 : 0; } selflag[key] = rank < 256 ? 1 : 0; }
    __syncthreads();
    const int h = tid >> 6; float mx = -INFINITY, l = 0.f, o = 0.f;
    for (int key = 0; key <= t; ++key) { if (!selflag[key]) continue; float a = 0.f;
        for (int dd = 0; dd < 64; ++dd) a += bf2f(Q[(size_t)tok * 512 + h * 64 + dd]) * bf2f(KP[(tokb + key) * 512 + h * 64 + dd]);
        const float mn = fmaxf(mx, a), f = expf(mx - mn), p = expf(a - mn); l = l * f + p; o = o * f + p * bf2f(VP[(tokb + key) * 512 + tid]); mx = mn; }
    o /= l; const float dd = o - bf2f(ACT[(size_t)tok * 1536 + tid]);
    const float e = blk_sum(dd * dd, sh), rr = blk_sum(o * o, sh); dbg_report(ws, slot, e, rr);
}

__global__ void __launch_bounds__(512) dbg_lin_t(const unsigned short* A, int K, const unsigned short* WT, int N, const unsigned short* O, int ldo, int act, unsigned char* ws, int slot) {
    __shared__ float arow[1024]; __shared__ float sh[8];
    const int r = dbg_row(blockIdx.x), tid = threadIdx.x;
    for (int k = tid; k < K; k += 512) arow[k] = bf2f(A[(size_t)r * K + k]);
    __syncthreads();
    float e2 = 0.f, r2 = 0.f;
    for (int n = tid; n < N; n += 512) { float y = 0.f; for (int k = 0; k < K; ++k) y += arow[k] * bf2f(WT[(size_t)n * K + k]);
        if (act == 1) y = 1.f / (1.f + expf(-y));
        const float dd = y - bf2f(O[(size_t)r * ldo + n]); e2 += dd * dd; r2 += y * y; }
    e2 = blk_sum(e2, sh); r2 = blk_sum(r2, sh); dbg_report(ws, slot, e2, r2);
}
__global__ void __launch_bounds__(512) dbg_wt(const unsigned short* WT, int K, const float* W, int ldw, int coff, const float* gsc, unsigned char* ws, int slot) {
    __shared__ float sh[8];
    const int n = blockIdx.x, tid = threadIdx.x; float e2 = 0.f, r2 = 0.f;
    for (int k = tid; k < K; k += 512) { const float v = W[(size_t)k * ldw + coff + n] * (gsc ? gsc[k] : 1.f); const float dd = v - bf2f(WT[(size_t)n * K + k]); e2 += dd * dd; r2 += v * v; }
    e2 = blk_sum(e2, sh); r2 = blk_sum(r2, sh); dbg_report(ws, slot, e2, r2);
}

__global__ void __launch_bounds__(256) dbg_tile(const unsigned short* A, const unsigned short* WT, const unsigned short* O, unsigned char* ws) {
    __shared__ float arow[1024]; __shared__ float sh2[4]; __shared__ float sh3[4];
    const int r = dbg_row(blockIdx.x / 12), pn = blockIdx.x % 12, tid = threadIdx.x, n = pn * 256 + tid;
    for (int k = tid; k < 1024; k += 256) arow[k] = bf2f(A[(size_t)r * 1024 + k]);
    __syncthreads();
    float y = 0.f; for (int k = 0; k < 1024; ++k) y += arow[k] * bf2f(WT[(size_t)n * 1024 + k]);
    if (MK_DBG_SIG) y = 1.f / (1.f + expf(-y));
    const float dd = y - bf2f(O[(size_t)r * 3072 + n]);
    float e2 = wave_sum(dd * dd), r2 = wave_sum(y * y);
    if ((tid & 63) == 0) { sh2[tid >> 6] = e2; sh3[tid >> 6] = r2; }
    __syncthreads();
    if (tid == 0) { e2 = sh2[0] + sh2[1] + sh2[2] + sh2[3]; r2 = sh3[0] + sh3[1] + sh3[2] + sh3[3];
        if (sqrtf(e2 / r2) > 0.03f) { const int pm = r / 256; int fi = 7;
            for (int c = 0; c < 256; ++c) { pg8::StaticOrder S; S.init(NT, 3072, 256, c); pg8::Unit u; for (int i = 0; S.next(i, u); ++i) if (u.pm == pm && u.pn == pn) fi = i; }
            atomicAdd((unsigned*)ws + DBG_W + 24 + fi, 1u); atomicAdd((unsigned*)ws + DBG_W + 23, 1u); } }
}

__global__ void __launch_bounds__(256) dbg_gates_naive(const unsigned short* A, const unsigned short* WT, unsigned short* O) {
    __shared__ float arow[8][1024];
    const int r0 = (blockIdx.x / 12) * 8, n = (blockIdx.x % 12) * 256 + threadIdx.x;
    for (int i = threadIdx.x; i < 8 * 1024; i += 256) arow[i >> 10][i & 1023] = bf2f(A[(size_t)(r0 + (i >> 10)) * 1024 + (i & 1023)]);
    __syncthreads();
    float acc[8] = {0.f, 0.f, 0.f, 0.f, 0.f, 0.f, 0.f, 0.f};
    const v4u* wp = (const v4u*)(WT + (size_t)n * 1024);
    for (int k8 = 0; k8 < 128; ++k8) { const v4u w = wp[k8];
#pragma unroll
        for (int e = 0; e < 4; ++e) { const float w0 = pg8::bf_lo(w[e]), w1 = pg8::bf_hi(w[e]);
#pragma unroll
            for (int i = 0; i < 8; ++i) acc[i] += arow[i][8 * k8 + 2 * e] * w0 + arow[i][8 * k8 + 2 * e + 1] * w1; } }
#pragma unroll
    for (int i = 0; i < 8; ++i) O[(size_t)(r0 + i) * 3072 + n] = (unsigned short)f2bf(1.f / (1.f + expf(-acc[i])));
}
__global__ void dbg_apply(float* out, const unsigned char* ws, float t0, float t1, float t2, float t3) {
    const unsigned* w = (const unsigned*)ws + DBG_W; float delta = 0.f;
    if (w[23] > 0u) delta += 0.1f; if (w[23] > 100u) delta += 0.2f; if (w[23] > 1228u) delta += 0.4f;
    const size_t n = (size_t)NT * D; for (size_t i = (size_t)blockIdx.x * blockDim.x + threadIdx.x; i < n; i += (size_t)gridDim.x * blockDim.x) out[i] *= (1.f + delta);
}
#endif

extern "C" void kernel_launch(void* const* d_in, const int* in_sizes, int n_in, void* d_out, int out_size, void* d_ws, size_t ws_size, hipStream_t stream) {
    static int grid = 0;
    if (grid == 0) {
        if (n_in != 31 || out_size != NT * D || ws_size < WS_END) { fprintf(stderr, "kernel_launch: unexpected problem (n_in %d out %d ws %zu)\n", n_in, out_size, ws_size); grid = -1; return; }
        int dev = 0, cus = 0, per_cu = 0;
        if (hipGetDevice(&dev) != hipSuccess || hipDeviceGetAttribute(&cus, hipDeviceAttributeMultiprocessorCount, dev) != hipSuccess) { grid = -1; return; }
        if (hipFuncSetAttribute((const void*)mk_fwd, hipFuncAttributeMaxDynamicSharedMemorySize, LDS_BYTES) != hipSuccess) { fprintf(stderr, "kernel_launch: hipFuncSetAttribute failed\n"); grid = -1; return; }
        if (hipOccupancyMaxActiveBlocksPerMultiprocessor(&per_cu, (const void*)mk_fwd, NWAVES * 64, LDS_BYTES) != hipSuccess || per_cu < 1) { fprintf(stderr, "kernel_launch: occupancy query says %d\n", per_cu); per_cu = 1; }
        (void)hipGetLastError();
        grid = cus;
        if (grid != 256) fprintf(stderr, "kernel_launch: note: %d CUs\n", grid);
    }
    if (grid < 0) return;
    (void)hipMemsetAsync((char*)d_ws + WS_CTL, 0, CTL_ZERO_BYTES, stream);
    Args a{};
    for (int i = 0; i < 31; ++i) a.in[i] = (const float*)d_in[i];
    a.out = (float*)d_out; a.ws = (unsigned char*)d_ws;
#if MK_ONE_LAUNCH
    a.ph_lo = 0; a.ph_hi = N_PHASES;
    void* kargs[] = {&a};
    hipError_t e = hipLaunchCooperativeKernel((const void*)mk_fwd, dim3(grid), dim3(NWAVES * 64), kargs, LDS_BYTES, stream);
    if (e != hipSuccess) fprintf(stderr, "kernel_launch: cooperative launch failed: %s\n", hipGetErrorString(e));
#else
    for (int p = 0; p < N_PHASES; ++p) { a.ph_lo = p; a.ph_hi = p + 1; hipLaunchKernelGGL(mk_fwd, dim3(grid), dim3(NWAVES * 64), LDS_BYTES, stream, a);
#if MK_DEBUG
        unsigned char* ws = (unsigned char*)d_ws; const float* const* in = (const float* const*)a.in;
        typedef const unsigned short* cus;
        if (p == 7) hipLaunchKernelGGL(dbg_tile, dim3(2048 * 12), dim3(256), 0, stream, (cus)(ws + WS_H), (cus)(ws + WS_WIN) + (size_t)2304 * 1024, (cus)(ws + WS_BIG), ws);
        if (p == N_PHASES - 1) hipLaunchKernelGGL(dbg_apply, dim3(1024), dim3(256), 0, stream, (float*)d_out, ws, 0.03f, 0.03f, 0.03f, 0.03f);
#endif
    }
#endif
}
```

```cpp
#include <hip/hip_runtime.h>
#include <hip/hip_cooperative_groups.h>
#include <cstdio>
#include <cstdint>
#include <cmath>
#ifndef MK_ONE_LAUNCH
#define MK_ONE_LAUNCH 1
#endif
#ifndef MK_PHMASK
#define MK_PHMASK 0x7fff
#endif
#ifndef MK_P5MASK
#define MK_P5MASK 31
#endif
#ifndef MK_ZERO_DSA
#define MK_ZERO_DSA 0
#endif
#ifndef MK_ZERO_MEM
#define MK_ZERO_MEM 0
#endif
#ifndef MK_DEBUG
#define MK_DEBUG 0
#endif
#ifndef MK_DBG_SIG
#define MK_DBG_SIG 1
#endif
#ifndef MK_REP_PHASE
#define MK_REP_PHASE -1
#endif
#ifndef MK_REP_MODE
#define MK_REP_MODE 0
#endif
#ifndef MK_SP2
#define MK_SP2 true
#endif
#ifndef MK_ALIGN
#define MK_ALIGN true
#endif

#define MK_WT_STORE 0
#define MK_SEL_BP 1
#define MK_IDX_SPLIT 1
#define MK_ATT_SKEW 0
__device__ __forceinline__ int mk_lane() { int l; asm volatile("v_mbcnt_lo_u32_b32 %0, -1, 0\n\tv_mbcnt_hi_u32_b32 %0, -1, %0" : "=v"(l)); return l; }
namespace pg8 {
#define PG8_LAS __attribute__((address_space(3)))
typedef unsigned short bf16_t;
typedef short bf16x8 __attribute__((ext_vector_type(8)));
typedef float f32x4 __attribute__((ext_vector_type(4)));
typedef unsigned u32x4 __attribute__((ext_vector_type(4)));
constexpr int BM = 256, BK = 64, HALF = 128, HTB = HALF * BK * 2  , STAGE_BYTES = 8 * HTB, NXCD = 8, WGM = 8;

__host__ __device__ __forceinline__ int lds_byte(int r, int c) { const int st = (r >> 4) * 2 + (c >> 5), rr = r & 15, cc = c & 31, ob = rr * 64 + cc * 2; return st * 1024 + (ob ^ (((ob >> 9) & 1) << 5)); }
__host__ __device__ __forceinline__ void stage_rc(int b, int& R, int& C) { const int st = b / 1024, sb = b % 1024, swz = sb ^ (((sb >> 9) & 1) << 5); R = (st >> 1) * 16 + swz / 64; C = (st & 1) * 32 + (swz % 64) / 2; }
__host__ __device__ __forceinline__ int perm32(int rho) { const int n = rho >> 4, i = rho & 15; return 8 * (i >> 2) + 4 * n + (i & 3); }

struct Unit { int pm, pn, seg; };
struct Gemm { const bf16_t* A; const bf16_t* Bt; int M, N, K, lda, ldb; int w0 = 0; };

struct StaticOrder {
    int nM, nN, nwg, G, c;
    __host__ __device__ void init(int M, int N, int G_, int c_) { nM = M / BM; nN = N / BM; nwg = nM * nN; G = G_; c = c_; }
    __host__ __device__ bool next(int i, Unit& u) const {
        const long L = (long)i * G + c; if (L >= nwg) return false;
        int wgid = (int)L; { const int q = nwg / NXCD, r = nwg % NXCD, xcd = wgid % NXCD, off = wgid / NXCD; wgid = (xcd < r ? xcd * (q + 1) : r * (q + 1) + (xcd - r) * q) + off; }
        const int nig = WGM * nN, gid = wgid / nig, fm = gid * WGM, gsz = (nM - fm) < WGM ? (nM - fm) : WGM;
        u.pm = fm + ((wgid % nig) % gsz); u.pn = (wgid % nig) / gsz; u.seg = 0; return true;
    }
    __device__ __forceinline__ void a_ready(const Unit&) const {}
    __device__ __forceinline__ void done(const Unit&) const {}
};
typedef float f32x2_cv __attribute__((ext_vector_type(2))); typedef __bf16 bf16x2_cv __attribute__((ext_vector_type(2)));
__device__ __forceinline__ unsigned cvt_pk_bf16(float lo, float hi) { const f32x2_cv v = {lo, hi}; return __builtin_bit_cast(unsigned, __builtin_convertvector(v, bf16x2_cv)); }
typedef float f32x2 __attribute__((ext_vector_type(2)));
template <class Epi, class Sched, bool ALIGN_EPI = false, bool SP2 = false>
__device__ __forceinline__ void gemm_phase(PG8_LAS unsigned char* lds, const Gemm g, const Sched& S, const Epi& E) {
    int tid_ = g.w0 * 64 + mk_lane(); asm volatile("" : "+v"(tid_));
    const int tid = tid_, wid = __builtin_amdgcn_readfirstlane(tid >> 6), lane = tid & 63, wr = wid >> 2, wc = wid & 3, fr = lane & 15, fq = lane >> 4;
    const int K = g.K, nt = K / BK;
    unsigned voffA[2], voffB[2];
#pragma unroll
    for (int i = 0; i < 2; ++i) { int R, C; stage_rc(tid * 16 + i * 8192, R, C); const int Rb = Epi::PERM ? ((R & ~31) + perm32(R & 31)) : R;
        voffA[i] = (unsigned)(R * g.lda + C) * 2u; voffB[i] = (unsigned)(Rb * g.ldb + C) * 2u; }
    const size_t kstep = (size_t)(BK * 2);
    const size_t hstepB = (size_t)HALF * g.ldb * 2, hstepA = (size_t)HALF * g.lda * 2;
    const size_t tstepB = 2 * hstepB, tstepA = 2 * hstepA;
    const unsigned ldsw = (unsigned)wid * 1024u;
    const int aoff = lds_byte(wr * 64 + fr, fq * 8), boff = lds_byte(wc * 32 + fr, fq * 8);
#define PG8_SA(b, h) (((b) * 2 + (h)) * HTB)
#define PG8_SB(b, h) ((4 + (b) * 2 + (h)) * HTB)
#define PG8_STAGE(bufoff, gbase, voff) do { _Pragma("unroll") for (int _i = 0; _i < 2; ++_i) \
        __builtin_amdgcn_global_load_lds((const unsigned*)((const char*)(gbase) + (voff)[_i]), (PG8_LAS unsigned*)(lds + (bufoff) + ldsw + _i * 8192), 16, 0, 0); } while (0)
#define PG8_LDA(dst, b, h) do { _Pragma("unroll") for (int m = 0; m < 4; ++m) _Pragma("unroll") for (int k = 0; k < 2; ++k) dst[m][k] = *(const PG8_LAS bf16x8*)(lds + PG8_SA(b, h) + aoff + m * 2048 + k * 1024); } while (0)
#define PG8_LDB(dst, b, h) do { _Pragma("unroll") for (int n = 0; n < 2; ++n) _Pragma("unroll") for (int k = 0; k < 2; ++k) dst[n][k] = *(const PG8_LAS bf16x8*)(lds + PG8_SB(b, h) + boff + n * 2048 + k * 1024); } while (0)
#define PG8_MMA(ai, bj, At, Bt) do { __builtin_amdgcn_s_setprio(1); _Pragma("unroll") for (int m = 0; m < 4; ++m) _Pragma("unroll") for (int n = 0; n < 2; ++n) _Pragma("unroll") for (int k = 0; k < 2; ++k) \
        acc[ai][bj][m][n] = __builtin_amdgcn_mfma_f32_16x16x32_bf16(Bt[n][k], At[m][k], acc[ai][bj][m][n], 0, 0, 0); __builtin_amdgcn_s_setprio(0); } while (0)
#define PG8_WAIT_V(n) asm volatile("s_waitcnt vmcnt(" #n ")" ::: "memory")
#define PG8_WAIT_L(n) asm volatile("s_waitcnt lgkmcnt(" #n ")" ::: "memory")
#define PG8_BAR __builtin_amdgcn_s_barrier()
#define PG8_SCHED __builtin_amdgcn_sched_barrier(0)
    Unit cur, nxt; int ui = 0;
    if (!S.next(0, cur)) return;
    f32x4 acc[2][2][4][2];
#pragma unroll
    for (int a = 0; a < 2; ++a)
#pragma unroll
        for (int b = 0; b < 2; ++b)
#pragma unroll
            for (int m = 0; m < 4; ++m)
#pragma unroll
                for (int n = 0; n < 2; ++n) acc[a][b][m][n] = (f32x4){0.f, 0.f, 0.f, 0.f};
    bf16x8 At[4][2], B0[2][2], B1[2][2];
    const char* cA = (const char*)g.A + (size_t)cur.pm * tstepA + E.koff(cur); const char* cB = (const char*)g.Bt + (size_t)cur.pn * tstepB + E.koff(cur);
    S.a_ready(cur);
    if constexpr (SP2) {
        PG8_STAGE(PG8_SB(0, 0), cB, voffB); PG8_STAGE(PG8_SB(0, 1), cB + hstepB, voffB); PG8_STAGE(PG8_SA(0, 0), cA, voffA); PG8_STAGE(PG8_SA(0, 1), cA + hstepA, voffA);
        if (wr == 1) PG8_BAR;
        PG8_WAIT_V(2); PG8_BAR;
        PG8_STAGE(PG8_SB(1, 0), cB + kstep, voffB); PG8_STAGE(PG8_SA(1, 0), cA + kstep, voffA); PG8_STAGE(PG8_SB(1, 1), cB + hstepB + kstep, voffB);
        PG8_WAIT_V(6); PG8_BAR;
    } else {
        PG8_STAGE(PG8_SB(0, 0), cB, voffB); PG8_STAGE(PG8_SA(0, 0), cA, voffA); PG8_STAGE(PG8_SB(0, 1), cB + hstepB, voffB); PG8_STAGE(PG8_SA(0, 1), cA + hstepA, voffA);
        if (wr == 1) PG8_BAR;
        PG8_WAIT_V(4); PG8_BAR;
        PG8_STAGE(PG8_SB(1, 0), cB + kstep, voffB); PG8_STAGE(PG8_SA(1, 0), cA + kstep, voffA); PG8_STAGE(PG8_SB(1, 1), cB + hstepB + kstep, voffB);
        PG8_WAIT_V(6); PG8_BAR;
    }
    for (;;) {
        const bool has_next = S.next(ui + 1, nxt);
        const char* nA = has_next ? (const char*)g.A + (size_t)nxt.pm * tstepA + E.koff(nxt) : cA; const char* nB = has_next ? (const char*)g.Bt + (size_t)nxt.pn * tstepB + E.koff(nxt) : cB;
        for (int t = 0; t < nt; t += 2) {
            if constexpr (Epi::HAS_MID) E.mid(acc, cur, t, wr, wc, fr, fq);
            const bool last = (t == nt - 2);
            const char* a1 = cA + (size_t)(t + 1) * kstep;
            const char* a2 = last ? nA : cA + (size_t)(t + 2) * kstep; const char* b2 = last ? nB : cB + (size_t)(t + 2) * kstep;
            const char* a3 = a2 + kstep; const char* b3 = b2 + kstep;
            if (last && has_next) S.a_ready(nxt);
            if constexpr (SP2) {
            PG8_LDB(B0, 0, 0); PG8_LDB(B1, 0, 1); PG8_SCHED; PG8_LDA(At, 0, 0); PG8_STAGE(PG8_SA(1, 1), a1 + hstepA, voffA);
            PG8_WAIT_V(8); PG8_WAIT_L(0); PG8_BAR; PG8_MMA(0, 0, At, B0); PG8_MMA(0, 1, At, B1); PG8_BAR; PG8_SCHED;
            PG8_LDA(At, 0, 1); PG8_STAGE(PG8_SB(0, 0), b2, voffB); PG8_STAGE(PG8_SB(0, 1), b2 + hstepB, voffB); PG8_STAGE(PG8_SA(0, 0), a2, voffA);
            PG8_WAIT_V(8); PG8_WAIT_L(0); PG8_BAR; PG8_MMA(1, 0, At, B0); PG8_MMA(1, 1, At, B1); PG8_BAR; PG8_SCHED;
            PG8_LDB(B0, 1, 0); PG8_LDB(B1, 1, 1); PG8_SCHED; PG8_LDA(At, 1, 0); PG8_STAGE(PG8_SA(0, 1), a2 + hstepA, voffA);
            PG8_WAIT_V(8); PG8_WAIT_L(0); PG8_BAR; PG8_MMA(0, 0, At, B0); PG8_MMA(0, 1, At, B1); PG8_BAR; PG8_SCHED;
            PG8_LDA(At, 1, 1); PG8_STAGE(PG8_SB(1, 0), b3, voffB); PG8_STAGE(PG8_SB(1, 1), b3 + hstepB, voffB); PG8_STAGE(PG8_SA(1, 0), a3, voffA);
            PG8_WAIT_V(8); PG8_WAIT_L(0); PG8_BAR; PG8_MMA(1, 0, At, B0); PG8_MMA(1, 1, At, B1); PG8_BAR; PG8_SCHED;
            } else {
            PG8_LDB(B0, 0, 0); PG8_SCHED; PG8_LDA(At, 0, 0); PG8_STAGE(PG8_SA(1, 1), a1 + hstepA, voffA);
            PG8_WAIT_L(8); PG8_BAR; PG8_WAIT_L(0); PG8_MMA(0, 0, At, B0); PG8_BAR; PG8_SCHED;
            PG8_LDB(B1, 0, 1); PG8_STAGE(PG8_SB(0, 0), b2, voffB);
            PG8_BAR; PG8_WAIT_L(0); PG8_MMA(0, 1, At, B1); PG8_BAR;
            PG8_LDA(At, 0, 1); PG8_STAGE(PG8_SA(0, 0), a2, voffA);
            PG8_BAR; PG8_WAIT_L(0); PG8_MMA(1, 0, At, B0); PG8_BAR; PG8_SCHED;
            PG8_STAGE(PG8_SB(0, 1), b2 + hstepB, voffB);
            PG8_WAIT_V(6); PG8_BAR; PG8_MMA(1, 1, At, B1); PG8_BAR;
            PG8_LDB(B0, 1, 0); PG8_SCHED; PG8_LDA(At, 1, 0); PG8_STAGE(PG8_SA(0, 1), a2 + hstepA, voffA);
            PG8_WAIT_L(8); PG8_BAR; PG8_WAIT_L(0); PG8_MMA(0, 0, At, B0); PG8_BAR; PG8_SCHED;
            PG8_LDB(B1, 1, 1); PG8_STAGE(PG8_SB(1, 0), b3, voffB);
            PG8_BAR; PG8_WAIT_L(0); PG8_MMA(0, 1, At, B1); PG8_BAR;
            PG8_LDA(At, 1, 1); PG8_STAGE(PG8_SA(1, 0), a3, voffA);
            PG8_BAR; PG8_WAIT_L(0); PG8_MMA(1, 0, At, B0); PG8_BAR; PG8_SCHED;
            PG8_STAGE(PG8_SB(1, 1), b3 + hstepB, voffB);
            PG8_WAIT_V(6); PG8_BAR; PG8_MMA(1, 1, At, B1); PG8_BAR;
            }
        }
        if constexpr (ALIGN_EPI) { if (wr == 0) PG8_BAR; }
        if constexpr (!Epi::AFTER_DRAIN) { E(acc, cur, wr, wc, fr, fq); S.done(cur); }
        if (!has_next) break;
        if (!E.keep(cur)) {
#pragma unroll
        for (int a = 0; a < 2; ++a)
#pragma unroll
            for (int b = 0; b < 2; ++b)
#pragma unroll
                for (int m = 0; m < 4; ++m)
#pragma unroll
                    for (int n = 0; n < 2; ++n) acc[a][b][m][n] = (f32x4){0.f, 0.f, 0.f, 0.f};
        }
        cur = nxt; cA = nA; cB = nB; ++ui;
        if constexpr (ALIGN_EPI) { if (wr == 1) PG8_BAR; }
    }
    PG8_WAIT_V(0);
    if constexpr (!ALIGN_EPI) { if (wr == 0) PG8_BAR; }
    PG8_BAR;
    if constexpr (Epi::AFTER_DRAIN) { E.fused(acc, cur, wr, wc, fr, fq, lds, wid, lane); S.done(cur); }
#undef PG8_SA
#undef PG8_SB
#undef PG8_STAGE
#undef PG8_LDA
#undef PG8_LDB
#undef PG8_MMA
#undef PG8_WAIT_V
#undef PG8_WAIT_L
#undef PG8_BAR
#undef PG8_SCHED
}
}

#define GAS __attribute__((address_space(1)))
#define LAS __attribute__((address_space(3)))
typedef unsigned short bf16;
typedef unsigned v4u __attribute__((ext_vector_type(4)));
typedef float f32x4 __attribute__((ext_vector_type(4)));
typedef short bf16x8 __attribute__((ext_vector_type(8)));
typedef GAS unsigned gu32;
typedef GAS unsigned long long gu64;
#define RLX_AGENT __ATOMIC_RELAXED, __HIP_MEMORY_SCOPE_AGENT
#define LDS_WAIT() asm volatile("s_waitcnt lgkmcnt(0)" ::: "memory")
#define VM_WAIT() asm volatile("s_waitcnt vmcnt(0)" ::: "memory")
__device__ __forceinline__ unsigned long long rt() { return __builtin_amdgcn_s_memrealtime(); }
__device__ __forceinline__ unsigned f2bf(float f) { unsigned u = __builtin_bit_cast(unsigned, f); return (u + 0x7fffu + ((u >> 16) & 1u)) >> 16; }
__device__ __forceinline__ unsigned pk2(float lo, float hi) { return f2bf(lo) | (f2bf(hi) << 16); }
#define XB_TMO      128
#define XB_XCNT(j)  (256  + 64 * (j))
#define XB_XSUB(j)  (1280 + 64 * (j))
#define XB_XGEN(j)  (2304 + 64 * (j))
#define XB_TOP      3328
#define XB_TOPGEN   3392
#define XCD_BAR_WORDS 3456
#define XB_SPIN_CAP (1u << 18)

__device__ __forceinline__ unsigned xb_ld(unsigned* p)              { return __hip_atomic_load(p, __ATOMIC_RELAXED, __HIP_MEMORY_SCOPE_AGENT); }
__device__ __forceinline__ unsigned xb_add(unsigned* p, unsigned v) { return __hip_atomic_fetch_add(p, v, __ATOMIC_RELAXED, __HIP_MEMORY_SCOPE_AGENT); }
__device__ __forceinline__ unsigned xb_xcc_id() { return (unsigned)__builtin_amdgcn_s_getreg((3 << 11) | 20) & 0xFu; }
#define XB_SPIN(cond, bar) do { unsigned _sp = 0; while (cond) { __builtin_amdgcn_s_sleep(1); \
    if ((++_sp & 255u) == 0u) { if (xb_ld(&(bar)[XB_TMO])) break; if (_sp > XB_SPIN_CAP) { atomicAdd(&(bar)[XB_TMO], 1u); break; } } } } while (0)

struct XcdBarrier {
    unsigned* bar; unsigned x; unsigned w0;
    volatile LAS unsigned* st;
};

__device__ __forceinline__ XcdBarrier xcd_barrier_post(unsigned* bar, volatile LAS unsigned* st, unsigned w0) {
    XcdBarrier b; b.bar = bar; b.x = xb_xcc_id(); b.st = st; b.w0 = w0;
    if (threadIdx.x == 0) (void)xb_add(&bar[XB_XCNT(b.x)], 1u);
    return b;
}
__device__ __forceinline__ void xcd_barrier_complete(unsigned* bar, unsigned x, unsigned& nloc, unsigned& nx) {
    const unsigned G = gridDim.x * gridDim.y * gridDim.z;
    unsigned sum, cnt, mine, sp = 0u;
    for (;;) {
        sum = 0u; cnt = 0u; mine = 0u;
#pragma unroll
        for (unsigned j = 0; j < 16; ++j) { const unsigned c = xb_ld(&bar[XB_XCNT(j)]); sum += c; cnt += (c > 0u) ? 1u : 0u; mine = (j == x) ? c : mine; }
        if (sum == G) break;
        __builtin_amdgcn_s_sleep(1);
        if ((++sp & 255u) == 0u) { if (xb_ld(&bar[XB_TMO])) break; if (sp > XB_SPIN_CAP) { atomicAdd(&bar[XB_TMO], 1u); break; } }
    }
    nloc = mine > 0u ? mine : 1u; nx = cnt > 0u ? cnt : 1u;
}

__device__ __forceinline__ void xcd_barrier(const XcdBarrier& b) {
    asm volatile("s_waitcnt vmcnt(0)" ::: "memory");
    __syncthreads();
    if (b.w0 == 0u && mk_lane() == 0) {
        unsigned* bar = b.bar;
        __builtin_amdgcn_s_waitcnt(0);
        unsigned nloc = b.st[0], nx = b.st[1];
        if (nloc == 0u) { xcd_barrier_complete(bar, b.x, nloc, nx); b.st[0] = nloc; b.st[1] = nx; }
        const unsigned old = xb_add(&bar[XB_XSUB(b.x)], 1u);
        const unsigned gen = old / nloc;
        if (old + 1u == (gen + 1u) * nloc) {
            __builtin_amdgcn_fence(__ATOMIC_RELEASE, "agent");
            asm volatile("s_waitcnt vmcnt(0)" ::: "memory");
            const unsigned og = xb_add(&bar[XB_TOP], 1u);
            const unsigned tg = og / nx;
            if (og + 1u == (tg + 1u) * nx) xb_add(&bar[XB_TOPGEN], 1u);
            else XB_SPIN(xb_ld(&bar[XB_TOPGEN]) == tg, bar);
            __builtin_amdgcn_fence(__ATOMIC_ACQUIRE, "agent");
            xb_add(&bar[XB_XGEN(b.x)], 1u);
            asm volatile("s_waitcnt vmcnt(0)" ::: "memory");
        } else {
            XB_SPIN(xb_ld(&bar[XB_XGEN(b.x)]) == gen, bar);
            __builtin_amdgcn_fence(__ATOMIC_ACQUIRE, "agent");
            asm volatile("s_waitcnt vmcnt(0)" ::: "memory");
        }
    }
    __syncthreads();
}

constexpr int NB = 16, T = 2048, NT = NB * T, D = 1024, FF = 2816, NMEM = 256;
constexpr float EPS = 1e-6f;
constexpr int NWAVES = 8;
constexpr float LOG2E = 1.4426950408889634f;

namespace pg8 {
__device__ __forceinline__ u32x4 pack8(const f32x4 v0, const f32x4 v1) {
    u32x4 w; w.x = cvt_pk_bf16(v0[0], v0[1]); w.y = cvt_pk_bf16(v0[2], v0[3]); w.z = cvt_pk_bf16(v1[0], v1[1]); w.w = cvt_pk_bf16(v1[2], v1[3]); return w;
}
__device__ __forceinline__ float sigmoidf_(float x) { return __builtin_amdgcn_rcpf(1.0f + __builtin_amdgcn_exp2f(-1.4426950408889634f * x)); }
__device__ __forceinline__ f32x2 sigmoid2_(const f32x2 x) { const f32x2 t = x * (-1.4426950408889634f); f32x2 d = {__builtin_amdgcn_exp2f(t[0]), __builtin_amdgcn_exp2f(t[1])}; d = d + 1.0f; return (f32x2){__builtin_amdgcn_rcpf(d[0]), __builtin_amdgcn_rcpf(d[1])}; }
__device__ __forceinline__ float bf_lo(unsigned w) { return __builtin_bit_cast(float, w << 16); }
__device__ __forceinline__ float bf_hi(unsigned w) { return __builtin_bit_cast(float, w & 0xffff0000u); }
__device__ __forceinline__ void st16_wt(void* p, const u32x4 v) {
#if MK_WT_STORE
    asm volatile("global_store_dwordx4 %0, %1, off sc1\n\ts_nop 1" :: "v"(p), "v"(v) : "memory");
#else
    *(u32x4*)p = v;
#endif
}

#define EPI_DEFAULTS \
    __device__ __forceinline__ size_t koff(const Unit&) const { return 0; } \
    __device__ __forceinline__ bool keep(const Unit&) const { return false; } \
    __device__ __forceinline__ void mid(f32x4 (&)[2][2][4][2], const Unit&, int, int, int, int, int) const {}
struct EpiSplit {
    EPI_DEFAULTS
    static constexpr bool PERM = true, AFTER_DRAIN = false, HAS_MID = false;
    bf16_t* O0; int ld0; int nt0; bf16_t* O1; int ld1; float s0, s1;
    __device__ __forceinline__ void operator()(const f32x4 (&acc)[2][2][4][2], const Unit& u, int wr, int wc, int fr, int fq) const {
        const bool first = u.pn < nt0;
        bf16_t* base = first ? O0 : O1; const int ld = first ? ld0 : ld1; const float sc = first ? s0 : s1;
        const int colt = (first ? u.pn : u.pn - nt0) * BM;
        const int row0 = u.pm * BM + wr * 64 + fr, col0 = colt + wc * 32 + 8 * fq;
#pragma unroll
        for (int ai = 0; ai < 2; ++ai)
#pragma unroll
            for (int m = 0; m < 4; ++m) { bf16_t* rowp = base + (size_t)(row0 + ai * HALF + m * 16) * ld + col0;
#pragma unroll
                for (int bj = 0; bj < 2; ++bj) *(u32x4*)(rowp + bj * HALF) = pack8(acc[ai][bj][m][0] * sc, acc[ai][bj][m][1] * sc); }
    }
};
struct EpiSwiglu {
    EPI_DEFAULTS
    static constexpr bool PERM = true, AFTER_DRAIN = false, HAS_MID = false;
    bf16_t* O; int ldc;
    __device__ __forceinline__ void operator()(const f32x4 (&acc)[2][2][4][2], const Unit& u, int wr, int wc, int fr, int fq) const {
        const int row0 = u.pm * BM + wr * 64 + fr, col0 = u.pn * HALF + wc * 32 + 8 * fq;
#pragma unroll
        for (int ai = 0; ai < 2; ++ai)
#pragma unroll
            for (int m = 0; m < 4; ++m) {
                f32x4 h[2];
#pragma unroll
                for (int n = 0; n < 2; ++n)
#pragma unroll
                    for (int j = 0; j < 4; j += 2) {
                        const f32x2 g2 = {acc[ai][0][m][n][j], acc[ai][0][m][n][j + 1]}, u2 = {acc[ai][1][m][n][j], acc[ai][1][m][n][j + 1]};
                        const f32x2 t2 = g2 * (-1.4426950408889634f);
                        f32x2 d2 = {__builtin_amdgcn_exp2f(t2[0]), __builtin_amdgcn_exp2f(t2[1])}; d2 = d2 + 1.0f;
                        const f32x2 r2 = {__builtin_amdgcn_rcpf(d2[0]), __builtin_amdgcn_rcpf(d2[1])};
                        const f32x2 o2 = (g2 * r2) * u2; h[n][j] = o2[0]; h[n][j + 1] = o2[1]; }
                st16_wt(O + (size_t)(row0 + ai * HALF + m * 16) * ldc + col0, pack8(h[0], h[1]));
            }
    }
};
struct EpiGates {
    EPI_DEFAULTS
    static constexpr bool PERM = true, AFTER_DRAIN = false, HAS_MID = false;
    bf16_t* O; int ldc;
    __device__ __forceinline__ void operator()(const f32x4 (&acc)[2][2][4][2], const Unit& u, int wr, int wc, int fr, int fq) const {
        const int row0 = u.pm * BM + wr * 64 + fr, col0 = u.pn * BM + wc * 32 + 8 * fq;
#pragma unroll
        for (int ai = 0; ai < 2; ++ai)
#pragma unroll
            for (int m = 0; m < 4; ++m) { bf16_t* rowp = O + (size_t)(row0 + ai * HALF + m * 16) * ldc + col0;
#pragma unroll
                for (int bj = 0; bj < 2; ++bj) { f32x4 a, b;
#pragma unroll
                    for (int j = 0; j < 4; j += 2) {
                        const f32x2 sa = sigmoid2_((f32x2){acc[ai][bj][m][0][j], acc[ai][bj][m][0][j + 1]}), sb = sigmoid2_((f32x2){acc[ai][bj][m][1][j], acc[ai][bj][m][1][j + 1]});
                        a[j] = fmaxf(sa[0], 1e-6f); a[j + 1] = fmaxf(sa[1], 1e-6f); b[j] = fmaxf(sb[0], 1e-6f); b[j + 1] = fmaxf(sb[1], 1e-6f); }
                    st16_wt(rowp + bj * HALF, pack8(a, b)); } }
    }
};
struct EpiWinA {
    EPI_DEFAULTS
    static constexpr bool PERM = true, AFTER_DRAIN = false, HAS_MID = false;
    bf16_t* CQ; bf16_t* CKV; float* KW; bf16_t* U; bf16_t* QM; const float* kvg; float qm_scale; PG8_LAS float* red;
    __device__ __forceinline__ void operator()(const f32x4 (&acc)[2][2][4][2], const Unit& u, int wr, int wc, int fr, int fq) const {
        const int row0 = u.pm * BM + wr * 64 + fr; const int cw = wc * 32 + 8 * fq;
        const int pn = u.pn;
        if (pn <= 1) {
#pragma unroll
            for (int ai = 0; ai < 2; ++ai)
#pragma unroll
                for (int m = 0; m < 4; ++m) { float s = 0.f;
#pragma unroll
                    for (int bj = 0; bj < 2; ++bj)
#pragma unroll
                        for (int n = 0; n < 2; ++n) { const f32x4 x = acc[ai][bj][m][n]; s += (x[0] * x[0] + x[1] * x[1]) + (x[2] * x[2] + x[3] * x[3]); }
                    s += __shfl_xor(s, 16); s += __shfl_xor(s, 32);
                    if (fq == 0) red[(ai * HALF + wr * 64 + m * 16 + fr) * 4 + wc] = s; }
            asm volatile("s_waitcnt lgkmcnt(0)" ::: "memory"); __builtin_amdgcn_s_barrier(); asm volatile("" ::: "memory");
            bf16_t* O = pn == 0 ? CQ : CKV;
            f32x4 gv[2][2];
#pragma unroll
            for (int bj = 0; bj < 2; ++bj)
#pragma unroll
                for (int n = 0; n < 2; ++n) gv[bj][n] = pn == 0 ? (f32x4){1.f, 1.f, 1.f, 1.f} : *(const f32x4*)(kvg + bj * HALF + cw + 4 * n);
#pragma unroll
            for (int ai = 0; ai < 2; ++ai)
#pragma unroll
                for (int m = 0; m < 4; ++m) { const int r = ai * HALF + wr * 64 + m * 16 + fr;
                    const f32x4 p = *(const PG8_LAS f32x4*)(red + r * 4);
                    const float rstd = __builtin_amdgcn_rsqf(((p[0] + p[1]) + (p[2] + p[3])) * (1.0f / 256.0f) + 1e-6f);
                    bf16_t* rowp = O + (size_t)(row0 + ai * HALF + m * 16) * 256 + cw;
#pragma unroll
                    for (int bj = 0; bj < 2; ++bj) *(u32x4*)(rowp + bj * HALF) = pack8(acc[ai][bj][m][0] * rstd * gv[bj][0], acc[ai][bj][m][1] * rstd * gv[bj][1]); }
        } else if (pn == 2) {
#pragma unroll
            for (int ai = 0; ai < 2; ++ai)
#pragma unroll
                for (int m = 0; m < 4; ++m) { float* rowp = KW + (size_t)(row0 + ai * HALF + m * 16) * 128 + cw;
                    *(f32x4*)(rowp) = acc[ai][0][m][0]; *(f32x4*)(rowp + 4) = acc[ai][0][m][1]; }
        } else if (pn <= 6) {
            const int col0 = (pn - 3) * HALF + cw;
#pragma unroll
            for (int ai = 0; ai < 2; ++ai)
#pragma unroll
                for (int m = 0; m < 4; ++m) { f32x4 h[2];
#pragma unroll
                    for (int n = 0; n < 2; ++n)
#pragma unroll
                        for (int j = 0; j < 4; j += 2) { const f32x2 sg = sigmoid2_((f32x2){acc[ai][1][m][n][j], acc[ai][1][m][n][j + 1]}); h[n][j] = acc[ai][0][m][n][j] * sg[0]; h[n][j + 1] = acc[ai][0][m][n][j + 1] * sg[1]; }
                    *(u32x4*)(U + (size_t)(row0 + ai * HALF + m * 16) * 512 + col0) = pack8(h[0], h[1]); }
        } else {
            const int col0 = (pn - 7) * BM + cw;
#pragma unroll
            for (int ai = 0; ai < 2; ++ai)
#pragma unroll
                for (int m = 0; m < 4; ++m) { bf16_t* rowp = QM + (size_t)(row0 + ai * HALF + m * 16) * 512 + col0;
#pragma unroll
                    for (int bj = 0; bj < 2; ++bj) *(u32x4*)(rowp + bj * HALF) = pack8(acc[ai][bj][m][0] * qm_scale, acc[ai][bj][m][1] * qm_scale); }
        }
    }
};
struct EpiMerge {
    static constexpr bool PERM = true, AFTER_DRAIN = false, HAS_MID = false;
    const bf16_t* G; bf16_t* O;
    __device__ __forceinline__ size_t koff(const Unit& u) const { return (size_t)u.seg * 1024; }
    __device__ __forceinline__ bool keep(const Unit& u) const { return u.seg < 2; }
    __device__ __forceinline__ void mid(f32x4 (&)[2][2][4][2], const Unit&, int, int, int, int, int) const {}
    __device__ __forceinline__ void operator()(f32x4 (&acc)[2][2][4][2], const Unit& u, int wr, int wc, int fr, int fq) const {
        const int row0 = u.pm * BM + wr * 64 + fr, col0 = u.pn * BM + wc * 32 + 8 * fq;
        const int from = u.seg; const bool last = u.seg == 2;
#pragma unroll
        for (int ai = 0; ai < 2; ++ai)
#pragma unroll
            for (int m = 0; m < 4; ++m) { const bf16_t* rowp = G + (size_t)(row0 + ai * HALF + m * 16) * 3072 + col0; bf16_t* orow = O + (size_t)(row0 + ai * HALF + m * 16) * 1024 + col0;
#pragma unroll
                for (int bj = 0; bj < 2; ++bj) {
                    const u32x4 gf = *(const u32x4*)(rowp + from * 1024 + bj * HALF);
                    u32x4 gt = (u32x4){0x3f803f80u, 0x3f803f80u, 0x3f803f80u, 0x3f803f80u};
                    if (!last) gt = *(const u32x4*)(rowp + (from + 1) * 1024 + bj * HALF);
#pragma unroll
                    for (int q = 0; q < 4; ++q) {
                        float r0 = bf_lo(gf[q]), r1 = bf_hi(gf[q]); if (!last) { r0 *= __builtin_amdgcn_rcpf(bf_lo(gt[q])); r1 *= __builtin_amdgcn_rcpf(bf_hi(gt[q])); }
                        acc[ai][bj][m][q >> 1][(q & 1) * 2] *= r0; acc[ai][bj][m][q >> 1][(q & 1) * 2 + 1] *= r1; }
                    if (last) *(u32x4*)(orow + bj * HALF) = pack8(acc[ai][bj][m][0], acc[ai][bj][m][1]); }
                asm volatile("" : "+v"(acc[ai][0][m][0]), "+v"(acc[ai][0][m][1]), "+v"(acc[ai][1][m][0]), "+v"(acc[ai][1][m][1]));
                if (m == 3) asm volatile("" ::: "memory"); }
    }
};
struct MergeOrder {
    StaticOrder base;
    __device__ bool next(int i, Unit& u) const { if (!base.next(i / 3, u)) return false; u.seg = i % 3; return true; }
    __device__ __forceinline__ void a_ready(const Unit&) const {}
    __device__ __forceinline__ void done(const Unit&) const {}
};
}

constexpr size_t MiB = 1u << 20;
constexpr size_t WS_CTL = 0, CTL_ZERO_BYTES = 1 * MiB;
constexpr size_t WS_WGU1 = 1 * MiB;
constexpr size_t WS_WDN1 = 12 * MiB;
constexpr size_t WS_WIN = 18 * MiB;
constexpr size_t WS_WQ = 29 * MiB;
constexpr size_t WS_WKV = WS_WQ + 512 * 1024;
constexpr size_t WS_WCAT = 30 * MiB;
constexpr size_t WS_WOUT = 33 * MiB;
constexpr size_t WS_WMK = 35 * MiB, WS_WMV = 36 * MiB;
constexpr size_t WS_WGU2 = 37 * MiB, WS_WDN2 = 48 * MiB;
constexpr size_t WS_H = 54 * MiB;
constexpr size_t WS_Y = 118 * MiB;
constexpr size_t WS_BIG = 182 * MiB;
constexpr size_t WS_CQ = WS_BIG, WS_CKV = WS_BIG + 16 * MiB, WS_KW = WS_BIG + 32 * MiB, WS_Q = WS_BIG + 48 * MiB, WS_KP = WS_BIG + 80 * MiB, WS_VP = WS_BIG + 112 * MiB,
                 WS_QIDX = WS_BIG + 144 * MiB, WS_KIDX = WS_BIG + 160 * MiB, WS_WIDX = WS_BIG + 164 * MiB, WS_MASKT = WS_BIG + 168 * MiB;
constexpr size_t WS_ACT = 374 * MiB;
constexpr size_t WS_MEMN = 470 * MiB, WS_MK = 478 * MiB, WS_MVT = 482 * MiB, WS_END = 486 * MiB;
static_assert(WS_WGU1 + (size_t)5632 * 1024 * 2 <= WS_WDN1 && WS_WDN1 + (size_t)1024 * 2816 * 2 <= WS_WIN && WS_WIN + (size_t)5376 * 1024 * 2 <= WS_WQ && WS_WKV + (size_t)1024 * 256 * 2 <= WS_WCAT &&
              WS_WCAT + (size_t)1024 * 1536 * 2 <= WS_WOUT && WS_WOUT + 2 * MiB <= WS_WMK && WS_WGU2 + 11 * MiB <= WS_WDN2 && WS_WDN2 + (size_t)1024 * 2816 * 2 <= WS_H, "weights map");
static_assert(WS_BIG + (size_t)NT * 2816 * 2 <= WS_ACT && WS_BIG + (size_t)NT * 3072 * 2 <= WS_ACT && WS_ACT + (size_t)NT * 1536 * 2 <= WS_MEMN && WS_WIDX + (size_t)NT * 16 <= WS_ACT, "act map");
constexpr int CW_BAR = 4096;

constexpr int RING_BYTES = 131072;
constexpr int LDSCTL_OFF = RING_BYTES, MISC_OFF = LDSCTL_OFF + 320, RED_OFF = RING_BYTES + 1024, PTAB_OFF = RING_BYTES + 8192;
constexpr int LDS_BYTES = 147456;

struct Frame {
    LAS unsigned char* lds;
    int tid, lane, wave, G, wave0;
    const float* in[31]; float* out; unsigned char* ws;
};

__device__ __forceinline__ float wave_sum(float v) {
#pragma unroll
    for (int o = 1; o < 64; o <<= 1) v += __shfl_xor(v, o);
    return v;
}
__device__ __forceinline__ float wave_max(float v) {
#pragma unroll
    for (int o = 1; o < 64; o <<= 1) v = fmaxf(v, __shfl_xor(v, o));
    return v;
}
__device__ __forceinline__ float wave_sum_dpp_f(float v) {
#define DPPF_(ctrl, rm) v += __builtin_bit_cast(float, __builtin_amdgcn_update_dpp(0, __builtin_bit_cast(int, v), ctrl, rm, 0xf, false))
    DPPF_(0xb1, 0xf); DPPF_(0x4e, 0xf); DPPF_(0x124, 0xf); DPPF_(0x128, 0xf); DPPF_(0x142, 0xa); DPPF_(0x143, 0xc);
#undef DPPF_
    return v;
}
__device__ __forceinline__ float bf2f(unsigned short b) { return __builtin_bit_cast(float, (unsigned)b << 16); }

__device__ __forceinline__ int map_col(int kind, int off, int np) {
    if (kind == 0) return off + np;
    const int tile = np >> 8, i = np & 255;
    if (kind == 1) return i < 128 ? tile * 128 + i : 2816 + tile * 128 + (i - 128);
    if (tile <= 1) return np;
    if (tile == 2) return i < 68 ? 512 + i : -1;
    if (tile <= 6) { const int j = tile - 3; return i < 128 ? 580 + j * 128 + i : 1092 + j * 128 + (i - 128); }
    return 1604 + (tile - 7) * 256 + i;
}
__device__ __forceinline__ void transpose_item(const float* W, int srcN, bf16* WT, int ldo, int koff, int nblk, int kind, int off, const float* rowscale, float scale, LAS float* scr, int item, int lane) {
    const int kb = item / nblk, nb = item % nblk, k0 = 64 * kb, n0 = 32 * nb;
    const int col = map_col(kind, off, n0 + (lane & 31));
    float wv_[32];
#pragma unroll
    for (int i = 0; i < 32; ++i) { const int kk = 2 * i + (lane >> 5); wv_[i] = col >= 0 ? W[(size_t)(k0 + kk) * srcN + col] : 0.f; }
    float rs_[32];
#pragma unroll
    for (int i = 0; i < 32; ++i) rs_[i] = rowscale ? rowscale[k0 + 2 * i + (lane >> 5)] : 1.f;
#pragma unroll
    for (int i = 0; i < 32; ++i) { const int kk = 2 * i + (lane >> 5);
        scr[kk * 33 + (lane & 31)] = wv_[i] * scale * rs_[i]; }
    LDS_WAIT(); asm volatile("" ::: "memory");
    const int c = lane & 7;
#pragma unroll
    for (int j = 0; j < 4; ++j) { const int n = (lane >> 3) + 8 * j; const LAS float* s = scr + (8 * c) * 33 + n;
        v4u o; o.x = pk2(s[0 * 33], s[1 * 33]); o.y = pk2(s[2 * 33], s[3 * 33]); o.z = pk2(s[4 * 33], s[5 * 33]); o.w = pk2(s[6 * 33], s[7 * 33]);
        *(v4u*)(WT + (size_t)(n0 + n) * ldo + koff + k0 + 8 * c) = o; }
    LDS_WAIT(); asm volatile("" ::: "memory");
}
__device__ __forceinline__ void rms_row_to_bf16(const float* xrow, bf16* orow, int lane) {
    const f32x4* xr = (const f32x4*)xrow + lane;
    f32x4 v[4]; float s = 0.f;
#pragma unroll
    for (int j = 0; j < 4; ++j) { v[j] = xr[64 * j]; s += (v[j].x * v[j].x + v[j].y * v[j].y) + (v[j].z * v[j].z + v[j].w * v[j].w); }
    const float rstd = 1.0f / sqrtf(wave_sum(s) * (1.f / 1024.f) + EPS);
    unsigned long long* o8 = (unsigned long long*)orow + lane;
#pragma unroll
    for (int j = 0; j < 4; ++j) o8[64 * j] = (unsigned long long)pk2(v[j].x * rstd, v[j].y * rstd) | ((unsigned long long)pk2(v[j].z * rstd, v[j].w * rstd) << 32);
}
struct TrJob { int src; int srcN; size_t dst; int ldo, koff, K, nout, kind, off, rs; float scale; };
__constant__ TrJob JOBS[16] = {
        {4, 5632, WS_WGU1, 1024, 0, 1024, 5632, 1, 0, 2, 1.f},
        {5, 1024, WS_WDN1, 2816, 0, 2816, 1024, 0, 0, -1, 1.f},
        {8, 5188, WS_WIN, 1024, 0, 1024, 2304, 2, 0, 6, 1.f},
        {8, 5188, WS_WIN + (size_t)2304 * 1024 * 2, 1024, 0, 1024, 3072, 0, 2116, 6, 1.f},
        {11, 512, WS_WQ, 256, 0, 256, 512, 0, 0, 9, 0.125f * LOG2E},
        {14, 256, WS_WQ + (size_t)512 * 256 * 2, 256, 0, 256, 256, 0, 0, 9, 0.125f},
        {12, 512, WS_WKV, 256, 0, 256, 512, 0, 0, -1, 1.f},
        {13, 512, WS_WKV + (size_t)512 * 256 * 2, 256, 0, 256, 512, 0, 0, -1, 1.f},
        {17, 1024, WS_WCAT, 1536, 0, 512, 1024, 0, 0, -1, 1.f},
        {22, 1024, WS_WCAT, 1536, 512, 512, 1024, 0, 0, -1, 1.f},
        {25, 1024, WS_WCAT, 1536, 1024, 512, 1024, 0, 0, -1, 1.f},
        {26, 1024, WS_WOUT, 1024, 0, 1024, 1024, 0, 0, -1, 1.f},
        {24, 1024, WS_WMK, 1024, 0, 1024, 512, 0, 0, 23, 1.f},
        {24, 1024, WS_WMV, 1024, 0, 1024, 512, 0, 512, 23, 1.f},
        {29, 5632, WS_WGU2, 1024, 0, 1024, 5632, 1, 0, 27, 1.f},
        {30, 1024, WS_WDN2, 2816, 0, 2816, 1024, 0, 0, -1, 1.f},
    };
__device__ __forceinline__ void p0_prologue(Frame& F) {
    { int t_ = F.wave0 * 64 + mk_lane(); asm volatile("" : "+v"(t_)); F.tid = t_; F.lane = t_ & 63; F.wave = __builtin_amdgcn_readfirstlane(t_ >> 6); }
    LAS float* scr = (LAS float*)(F.lds + F.wave * 16384);
    const int gw = blockIdx.x * NWAVES + F.wave, NGW = F.G * NWAVES;
    constexpr int NJ = 16;
    LAS unsigned long long* ptab = (LAS unsigned long long*)(F.lds + PTAB_OFF);
    if (F.tid == 0) {
#pragma unroll
        for (int i = 0; i < 31; ++i) ptab[i] = (unsigned long long)(uintptr_t)F.in[i]; }
    __syncthreads();
    int base = 0;
#pragma unroll 1
    for (int j = 0; j < NJ; ++j) {
        const TrJob jb = JOBS[j];
        const int nblk = jb.nout / 32, nitems = (jb.K / 64) * nblk;
        int first = (gw - (base % NGW) + NGW) % NGW;
        for (int it = first; it < nitems; it += NGW)
            transpose_item((const float*)(uintptr_t)ptab[jb.src], jb.srcN, (bf16*)(F.ws + jb.dst), jb.ldo, jb.koff, nblk, jb.kind, jb.off, jb.rs >= 0 ? (const float*)(uintptr_t)ptab[jb.rs] : nullptr, jb.scale, scr, it, F.lane);
        base += nitems;
    }
    bf16* H = (bf16*)(F.ws + WS_H); bf16* MEMN = (bf16*)(F.ws + WS_MEMN);
    { f32x4 v[4], vn[4];
      if (gw < NT) {
#pragma unroll
          for (int j = 0; j < 4; ++j) v[j] = ((const f32x4*)(F.in[0] + (size_t)gw * D))[F.lane + 64 * j]; }
      for (int m = gw; m < NT; m += NGW) { const int mn = m + NGW;
          if (mn < NT) {
#pragma unroll
              for (int j = 0; j < 4; ++j) vn[j] = ((const f32x4*)(F.in[0] + (size_t)mn * D))[F.lane + 64 * j]; }
          float s = 0.f;
#pragma unroll
          for (int j = 0; j < 4; ++j) s += (v[j].x * v[j].x + v[j].y * v[j].y) + (v[j].z * v[j].z + v[j].w * v[j].w);
          const float rstd = 1.0f / sqrtf(__shfl(wave_sum_dpp_f(s), 63) * (1.f / 1024.f) + EPS);
          unsigned long long* o8 = (unsigned long long*)(H + (size_t)m * D) + F.lane;
#pragma unroll
          for (int j = 0; j < 4; ++j) o8[64 * j] = (unsigned long long)pk2(v[j].x * rstd, v[j].y * rstd) | ((unsigned long long)pk2(v[j].z * rstd, v[j].w * rstd) << 32);
#pragma unroll
          for (int j = 0; j < 4; ++j) v[j] = vn[j]; } }
    for (int m = gw; m < NB * NMEM; m += NGW) rms_row_to_bf16(F.in[1] + (size_t)m * D, MEMN + (size_t)m * D, F.lane);
}

template <bool XI16, bool XO16>
__device__ __forceinline__ void ew_phase(Frame& F, const bf16* Y, const void* xin_, const float* gain, float coef, void* xout_, bf16* hout) {
    { int t_ = F.wave0 * 64 + mk_lane(); asm volatile("" : "+v"(t_)); F.tid = t_; F.lane = t_ & 63; F.wave = __builtin_amdgcn_readfirstlane(t_ >> 6); }
    const int gw = blockIdx.x * NWAVES + F.wave, NGW = F.G * NWAVES, lane = F.lane;
    f32x4 gv[4];
#pragma unroll
    for (int j = 0; j < 4; ++j) gv[j] = ((const f32x4*)gain)[lane + 64 * j] * coef;
    unsigned long long yw[4], ywn[4], xw[4], xwn[4]; f32x4 xv[4], xvn[4];
#define EW_LOAD(m_, yw_, xv_, xw_) do { _Pragma("unroll") for (int j = 0; j < 4; ++j) { yw_[j] = ((const unsigned long long*)(Y + (size_t)(m_) * D))[lane + 64 * j]; \
        if (XI16) xw_[j] = ((const unsigned long long*)((const bf16*)xin_ + (size_t)(m_) * D))[lane + 64 * j]; else xv_[j] = ((const f32x4*)((const float*)xin_ + (size_t)(m_) * D))[lane + 64 * j]; } } while (0)
#define EW_UNPK(w_, v_) do { v_.x = bf2f((unsigned short)(w_)); v_.y = bf2f((unsigned short)((w_) >> 16)); v_.z = bf2f((unsigned short)((w_) >> 32)); v_.w = bf2f((unsigned short)((w_) >> 48)); } while (0)
    if (gw < NT) EW_LOAD(gw, yw, xv, xw);
    for (int m = gw; m < NT; m += NGW) {
        const int mn = m + NGW;
        if (mn < NT) EW_LOAD(mn, ywn, xvn, xwn);
        f32x4 yv[4]; float s = 0.f;
#pragma unroll
        for (int j = 0; j < 4; ++j) { EW_UNPK(yw[j], yv[j]); if (XI16) EW_UNPK(xw[j], xv[j]);
            s += (yv[j].x * yv[j].x + yv[j].y * yv[j].y) + (yv[j].z * yv[j].z + yv[j].w * yv[j].w); }
        const float rstd = 1.0f / sqrtf(__shfl(wave_sum_dpp_f(s), 63) * (1.f / 1024.f) + EPS);
        float s2 = 0.f;
#pragma unroll
        for (int j = 0; j < 4; ++j) { xv[j] = xv[j] + gv[j] * yv[j] * rstd; s2 += (xv[j].x * xv[j].x + xv[j].y * xv[j].y) + (xv[j].z * xv[j].z + xv[j].w * xv[j].w); }
        if (XO16) { unsigned long long* xo = (unsigned long long*)((bf16*)xout_ + (size_t)m * D) + lane;
#pragma unroll
            for (int j = 0; j < 4; ++j) xo[64 * j] = (unsigned long long)pk2(xv[j].x, xv[j].y) | ((unsigned long long)pk2(xv[j].z, xv[j].w) << 32);
        } else { f32x4* xo = (f32x4*)((float*)xout_ + (size_t)m * D) + lane;
#pragma unroll
            for (int j = 0; j < 4; ++j) xo[64 * j] = xv[j]; }
        if (hout) {
            const float r2 = 1.0f / sqrtf(__shfl(wave_sum_dpp_f(s2), 63) * (1.f / 1024.f) + EPS);
            unsigned long long* o8 = (unsigned long long*)(hout + (size_t)m * D) + lane;
#pragma unroll
            for (int j = 0; j < 4; ++j) o8[64 * j] = (unsigned long long)pk2(xv[j].x * r2, xv[j].y * r2) | ((unsigned long long)pk2(xv[j].z * r2, xv[j].w * r2) << 32);
        }
#pragma unroll
        for (int j = 0; j < 4; ++j) { yw[j] = ywn[j]; xv[j] = xvn[j]; xw[j] = xwn[j]; }
    }
#undef EW_LOAD
#undef EW_UNPK
}

__device__ __forceinline__ void kidx_phase(Frame& F) {
    { int t_ = F.wave0 * 64 + mk_lane(); asm volatile("" : "+v"(t_)); F.tid = t_; F.lane = t_ & 63; F.wave = __builtin_amdgcn_readfirstlane(t_ >> 6); }
    const int gw = blockIdx.x * NWAVES + F.wave, NGW = F.G * NWAVES, lane = F.lane;
    const float* KW = (const float*)(F.ws + WS_KW); bf16* KIDX = (bf16*)(F.ws + WS_KIDX); float* WIDX = (float*)(F.ws + WS_WIDX);
    const float g = F.in[15][lane], b = F.in[16][lane];
    for (int m0 = gw; m0 < NT; m0 += 16 * NGW) {
        float vv[16], ww[16];
#pragma unroll
        for (int k = 0; k < 16; ++k) { const int m = m0 + k * NGW; vv[k] = m < NT ? KW[(size_t)m * 128 + lane] : 0.f; ww[k] = (m < NT && lane < 4) ? KW[(size_t)m * 128 + 64 + lane] : 0.f; }
#pragma unroll
        for (int k = 0; k < 16; ++k) { const int m = m0 + k * NGW; if (m < NT) {
            const float v = vv[k];
            const float mean = wave_sum(v) * (1.f / 64.f); const float xc = v - mean;
            const float var = wave_sum(xc * xc) * (1.f / 64.f);
            KIDX[((size_t)(m >> 5) * 8 + (lane >> 3)) * 256 + (m & 31) * 8 + (lane & 7)] = (bf16)f2bf(xc * (1.0f / sqrtf(var + EPS)) * g + b);
            if (lane < 4) WIDX[(size_t)m * 4 + lane] = ww[k] * 0.5f; } }
    }
}

__device__ __forceinline__ void conv_phase(Frame& F) {
    { int t_ = F.wave0 * 64 + mk_lane(); asm volatile("" : "+v"(t_)); F.tid = t_; F.lane = t_ & 63; F.wave = __builtin_amdgcn_readfirstlane(t_ >> 6); }
    const int ch = F.tid, lane = F.lane, wave = F.wave;
    const bf16* U = (const bf16*)(F.ws + WS_Y); bf16* ACT = (bf16*)(F.ws + WS_ACT);
    float wv[31];
#pragma unroll
    for (int j = 0; j < 31; ++j) wv[j] = F.in[18][j * 512 + ch];
    pg8::f32x2 we2[15], wo2[15];
#pragma unroll
    for (int p2 = 0; p2 < 15; ++p2) { we2[p2] = (pg8::f32x2){wv[2 * p2], wv[2 * p2 + 1]}; wo2[p2] = (pg8::f32x2){wv[2 * p2 + 1], wv[2 * p2 + 2]}; }
    const float w0 = wv[0], w30 = wv[30];
    const float bias = F.in[19][ch], lg = F.in[20][ch], lb = F.in[21][ch];
    LAS float* red = (LAS float*)F.lds;
    LAS float* stat = (LAS float*)(F.lds + 4096);
    int par = 0;
    for (int unit = blockIdx.x; unit < NT / 128; unit += F.G) {
        const int tok0 = unit * 128, tb = tok0 % T;
        pg8::f32x2 x2[23];
        float xn[16];
#pragma unroll
        for (int k = 0; k < 30; ++k) { const int pp = tb - 30 + k; const float v = pp >= 0 ? bf2f(U[(size_t)(tok0 - 30 + k) * 512 + ch]) : 0.f; x2[8 + (k >> 1)][k & 1] = v; }
#pragma unroll
        for (int i = 0; i < 16; ++i) xn[i] = bf2f(U[(size_t)(tok0 + i) * 512 + ch]);
#pragma unroll 1
        for (int grp = 0; grp < 8; ++grp) {
#pragma unroll
            for (int k = 0; k < 15; ++k) x2[k] = x2[k + 8];
#pragma unroll
            for (int i = 0; i < 8; ++i) x2[15 + i] = (pg8::f32x2){xn[2 * i], xn[2 * i + 1]};
            if (grp < 7) {
#pragma unroll
                for (int i = 0; i < 16; ++i) xn[i] = bf2f(U[(size_t)(tok0 + (grp + 1) * 16 + i) * 512 + ch]); }
            float y[16];
#pragma unroll
            for (int a2 = 0; a2 < 8; ++a2) {
                pg8::f32x2 e = {bias, 0.f}, o = {bias, 0.f};
#pragma unroll
                for (int p2 = 0; p2 < 15; ++p2) { e = __builtin_elementwise_fma(we2[p2], x2[a2 + p2], e); o = __builtin_elementwise_fma(wo2[p2], x2[a2 + 1 + p2], o); }
                y[2 * a2] = (e[0] + e[1]) + w30 * x2[a2 + 15][0];
                y[2 * a2 + 1] = (o[0] + o[1]) + w0 * x2[a2][1]; }
            { LAS float* Tw = (LAS float*)(F.lds + 8192) + wave * (16 * 68);
#pragma unroll
              for (int i = 0; i < 16; ++i) Tw[i * 68 + lane] = y[i];
              asm volatile("s_waitcnt lgkmcnt(0)" ::: "memory");
              const int tt = lane & 15, q4 = lane >> 4; float s1 = 0.f, s2 = 0.f;
#pragma unroll
              for (int k = 0; k < 4; ++k) { const f32x4 v = *(const LAS f32x4*)(Tw + tt * 68 + 16 * q4 + 4 * k);
                  s1 += (v.x + v.y) + (v.z + v.w); s2 += (v.x * v.x + v.y * v.y) + (v.z * v.z + v.w * v.w); }
              s1 += __shfl_xor(s1, 16); s2 += __shfl_xor(s2, 16); s1 += __shfl_xor(s1, 32); s2 += __shfl_xor(s2, 32);
              if (lane < 16) { red[((par * 16 + tt) * 8 + wave) * 2] = s1; red[((par * 16 + tt) * 8 + wave) * 2 + 1] = s2; } }
            __syncthreads();
            if (F.tid < 16) { float t1 = 0.f, t2 = 0.f;
#pragma unroll
                for (int w = 0; w < 8; ++w) { t1 += red[((par * 16 + F.tid) * 8 + w) * 2]; t2 += red[((par * 16 + F.tid) * 8 + w) * 2 + 1]; }
                const float mean = t1 * (1.f / 512.f), var = fmaxf(t2 * (1.f / 512.f) - mean * mean, 0.f);
                stat[(par * 16 + F.tid) * 2] = mean; stat[(par * 16 + F.tid) * 2 + 1] = 1.0f / sqrtf(var + EPS); }
            __syncthreads();
#pragma unroll
            for (int i = 0; i < 16; ++i) { const float mean = stat[(par * 16 + i) * 2], rstd = stat[(par * 16 + i) * 2 + 1];
                float v = (y[i] - mean) * rstd * lg + lb;
                v = v * pg8::sigmoidf_(v);
                ACT[(size_t)(tok0 + grp * 16 + i) * 1536 + 512 + ch] = (bf16)f2bf(v); }
            par ^= 1;
        }
    }
    __syncthreads();
}

typedef __bf16 bf16x2_dt __attribute__((ext_vector_type(2)));
__device__ __forceinline__ float dot2_ones(unsigned pair, float acc) { return __builtin_amdgcn_fdot2_f32_bf16(__builtin_bit_cast(bf16x2_dt, pair), __builtin_bit_cast(bf16x2_dt, 0x3f803f80u), acc, false); }
constexpr float ATT_THR = 8.0f;
typedef float f32x16 __attribute__((ext_vector_type(16)));
typedef short s16x4 __attribute__((ext_vector_type(4)));
constexpr int MA_K = 0, MA_V = 65536;
__device__ __forceinline__ void memattn_phase(Frame& F) {
    int tid; { int t_ = F.wave0 * 64 + mk_lane(); asm volatile("" : "+v"(t_)); tid = t_; }
    const int lane = tid & 63, wave = __builtin_amdgcn_readfirstlane(tid >> 6), r32 = lane & 31, hi = lane >> 5;
    const bf16* QM = (const bf16*)(F.ws + WS_Y) + (size_t)NT * 512;
    const bf16* MK = (const bf16*)(F.ws + WS_MK);
    const bf16* MVT = (const bf16*)(F.ws + WS_MVT);
    bf16* ACT = (bf16*)(F.ws + WS_ACT);
    const unsigned sw = (unsigned)(r32 & 15);
    for (int task = blockIdx.x; task < NB * 4 * 4; task += F.G) {
        const int bh = task >> 2, b = bh >> 2, h = bh & 3, qpart = task & 3;
#pragma unroll
        for (int n = 0; n < 8; ++n) { const int idx = tid + 512 * n, row = idx >> 4, c = idx & 15;
            const v4u kv = *(const v4u*)(MK + (size_t)(b * 256 + row) * 512 + h * 128 + 8 * c);
            *(LAS v4u*)(F.lds + MA_K + row * 256 + ((c ^ (row & 15)) << 4)) = kv; }
#pragma unroll
        for (int n = 0; n < 8; ++n) { const int idx = tid + 512 * n, row = idx >> 5, gc = idx & 31, sg = gc >> 1, a = gc & 1;
            const v4u vv = *(const v4u*)(MVT + (size_t)(h * 128 + row) * (NB * 256) + b * 256 + 8 * gc);
            *(LAS unsigned long long*)(F.lds + MA_V + row * 512 + (((2 * sg) ^ (row & 15)) << 4) + 8 * a) = (unsigned long long)vv.x | ((unsigned long long)vv.y << 32);
            *(LAS unsigned long long*)(F.lds + MA_V + row * 512 + (((2 * sg + 1) ^ (row & 15)) << 4) + 8 * a) = (unsigned long long)vv.z | ((unsigned long long)vv.w << 32); }
        __syncthreads();
#pragma unroll 1
        for (int grp = 0; grp < 2; ++grp) {
            const size_t tok = (size_t)b * T + qpart * 512 + wave * 64 + grp * 32 + r32;
            bf16x8 qf[8];
#pragma unroll
            for (int ks = 0; ks < 8; ++ks) qf[ks] = *(const bf16x8*)(QM + tok * 512 + h * 128 + 16 * ks + 8 * hi);
            f32x16 o[4]; o[0] = f32x16{}; o[1] = f32x16{}; o[2] = f32x16{}; o[3] = f32x16{};
            float m = -1e30f, l = 0.f;
#pragma unroll 1
            for (int jt = 0; jt < 4; ++jt) {
                f32x16 p0 = {}, p1 = {};
                const LAS unsigned char* kb = F.lds + MA_K + (64 * jt + r32) * 256;
#pragma unroll
                for (int ks = 0; ks < 8; ++ks) { const unsigned ch = (((unsigned)(2 * ks + hi)) ^ sw) << 4;
                    p0 = __builtin_amdgcn_mfma_f32_32x32x16_bf16(*(const LAS bf16x8*)(kb + ch), qf[ks], p0, 0, 0, 0);
                    p1 = __builtin_amdgcn_mfma_f32_32x32x16_bf16(*(const LAS bf16x8*)(kb + 32 * 256 + ch), qf[ks], p1, 0, 0, 0); }
                float mx = fmaxf(p0[0], p1[0]);
#pragma unroll
                for (int r = 1; r < 16; ++r) mx = fmaxf(mx, fmaxf(p0[r], p1[r]));
                mx = fmaxf(mx, __shfl_xor(mx, 32));
                if (jt == 0 || __any(mx > m + ATT_THR)) { const float mn = fmaxf(m, mx), al = __builtin_amdgcn_exp2f(m - mn); m = mn; l *= al;
#pragma unroll
                    for (int db = 0; db < 4; ++db)
#pragma unroll
                        for (int r = 0; r < 16; ++r) o[db][r] *= al; }
#pragma unroll
                for (int r = 0; r < 16; ++r) { p0[r] = __builtin_amdgcn_exp2f(p0[r] - m); p1[r] = __builtin_amdgcn_exp2f(p1[r] - m); }
#pragma unroll
                for (int s = 0; s < 4; ++s) {
                    v4u pw;
                    if (s < 2) { pw.x = pg8::cvt_pk_bf16(p0[8 * s + 0], p0[8 * s + 1]); pw.y = pg8::cvt_pk_bf16(p0[8 * s + 2], p0[8 * s + 3]); pw.z = pg8::cvt_pk_bf16(p0[8 * s + 4], p0[8 * s + 5]); pw.w = pg8::cvt_pk_bf16(p0[8 * s + 6], p0[8 * s + 7]); }
                    else { const int s2 = s - 2; pw.x = pg8::cvt_pk_bf16(p1[8 * s2 + 0], p1[8 * s2 + 1]); pw.y = pg8::cvt_pk_bf16(p1[8 * s2 + 2], p1[8 * s2 + 3]); pw.z = pg8::cvt_pk_bf16(p1[8 * s2 + 4], p1[8 * s2 + 5]); pw.w = pg8::cvt_pk_bf16(p1[8 * s2 + 6], p1[8 * s2 + 7]); }
                    l = dot2_ones(pw.x, l); l = dot2_ones(pw.y, l); l = dot2_ones(pw.z, l); l = dot2_ones(pw.w, l);
                    const bf16x8 pf = __builtin_bit_cast(bf16x8, pw);
                    const unsigned ch = (((unsigned)(8 * jt + 2 * s + hi)) ^ sw) << 4;
#pragma unroll
                    for (int db = 0; db < 4; ++db) o[db] = __builtin_amdgcn_mfma_f32_32x32x16_bf16(*(const LAS bf16x8*)(F.lds + MA_V + (32 * db + r32) * 512 + ch), pf, o[db], 0, 0, 0);
                }
            }
            l += __shfl_xor(l, 32);
            const float rl = 1.0f / l;
            bf16* orow = ACT + tok * 1536 + 1024 + h * 128 + 4 * hi;
#pragma unroll
            for (int db = 0; db < 4; ++db)
#pragma unroll
                for (int g4 = 0; g4 < 4; ++g4)
                    *(unsigned long long*)(orow + 32 * db + 8 * g4) = (unsigned long long)pk2(o[db][4 * g4] * rl, o[db][4 * g4 + 1] * rl) | ((unsigned long long)pk2(o[db][4 * g4 + 2] * rl, o[db][4 * g4 + 3] * rl) << 32);
        }
        __syncthreads();
    }
}

__device__ __forceinline__ int wave_sum_dpp(int v) {
    v += __builtin_amdgcn_update_dpp(0, v, 0xb1, 0xf, 0xf, false);
    v += __builtin_amdgcn_update_dpp(0, v, 0x4e, 0xf, 0xf, false);
    v += __builtin_amdgcn_update_dpp(0, v, 0x124, 0xf, 0xf, false);
    v += __builtin_amdgcn_update_dpp(0, v, 0x128, 0xf, 0xf, false);
    v += __builtin_amdgcn_update_dpp(0, v, 0x142, 0xa, 0xf, false);
    v += __builtin_amdgcn_update_dpp(0, v, 0x143, 0xc, 0xf, false);
    return __builtin_amdgcn_readlane(v, 63);
}
template <int KR> __device__ __forceinline__ void tie_words(const unsigned (&u)[KR], unsigned tau, int ge, int t, int lane, unsigned long long& myword) {
    unsigned wlo = 0u, whi = 0u;
    if (ge == 256) {
#pragma unroll
        for (int k = 0; k < KR; ++k) { const unsigned long long sm = __ballot(u[k] >= tau);
            asm("s_nop 1\n\tv_writelane_b32 %0, %2, %4\n\tv_writelane_b32 %1, %3, %4" : "+v"(wlo), "+v"(whi) : "s"((unsigned)sm), "s"((unsigned)(sm >> 32)), "i"(k)); }
    } else {
        int cgt = 0;
#pragma unroll
        for (int k = 0; k < KR; ++k) cgt += __popcll(__ballot(u[k] > tau));
        const int need = 256 - cgt; int run = 0;
        const unsigned long long lt = (1ull << lane) - 1ull;
#pragma unroll
        for (int k = 0; k < KR; ++k) { const int key = lane + 64 * k; const bool valid = key <= t;
            const bool eq = valid && u[k] == tau; const unsigned long long em = __ballot(eq);
            const bool sel = valid && (u[k] > tau || (eq && run + __popcll(em & lt) < need));
            const unsigned long long sm = __ballot(sel);
            asm("s_nop 1\n\tv_writelane_b32 %0, %2, %4\n\tv_writelane_b32 %1, %3, %4" : "+v"(wlo), "+v"(whi) : "s"((unsigned)sm), "s"((unsigned)(sm >> 32)), "i"(k));
            run += __popcll(em); }
    }
    myword = (unsigned long long)wlo | ((unsigned long long)whi << 32);
}
typedef unsigned short us2_t __attribute__((ext_vector_type(2)));
template <int NP> __device__ __forceinline__ int count_ge16(const unsigned (&pk)[NP], unsigned cand) {
    const unsigned cm1 = cand - 1u; unsigned c2 = cm1 | (cm1 << 16), one = 0x00010001u;
    unsigned a0 = 0u, a1 = 0u, d0, d1;
#pragma unroll
    for (int i = 0; i < NP; i += 2) {
        asm("v_pk_sub_u16 %0, %2, %3 clamp\n\tv_pk_min_u16 %0, %0, %4\n\tv_pk_add_u16 %1, %1, %0" : "=&v"(d0), "+v"(a0) : "v"(pk[i]), "v"(c2), "v"(one));
        asm("v_pk_sub_u16 %0, %2, %3 clamp\n\tv_pk_min_u16 %0, %0, %4\n\tv_pk_add_u16 %1, %1, %0" : "=&v"(d1), "+v"(a1) : "v"(pk[i + 1]), "v"(c2), "v"(one)); }
    unsigned a; asm("v_pk_add_u16 %0, %1, %2" : "=v"(a) : "v"(a0), "v"(a1));
    return wave_sum_dpp((int)((a & 0xffffu) + (a >> 16)));
}
template <int KR> __device__ __forceinline__ unsigned long long select_topk(const LAS float* Sw, int t, int lane) {
    unsigned u[KR];
#pragma unroll
    for (int k = 0; k < KR; ++k) { const int key = lane + 64 * k; const unsigned bits = __builtin_bit_cast(unsigned, Sw[key]);
        const unsigned o = (bits & 0x80000000u) ? ~bits : (bits | 0x80000000u); u[k] = key <= t ? o : 0u; }
    unsigned pk[KR / 2];
#pragma unroll
    for (int i = 0; i < KR / 2; ++i) pk[i] = (u[2 * i] >> 16) | (u[2 * i + 1] & 0xffff0000u);
    unsigned tauh = 0u; int ge = t + 1;
#pragma unroll 1
    for (int bit = 15; bit >= 0 && ge != 256; --bit) { const unsigned cand = tauh | (1u << bit);
        const int cnt = count_ge16<KR / 2>(pk, cand);
        if (cnt >= 256) { tauh = cand; ge = cnt; } }
    unsigned tau = tauh << 16; int gefull = ge;
    if (ge != 256) {
        const int G = tauh == 0xffffu ? 0 : count_ge16<KR / 2>(pk, tauh + 1u);
        const int need2 = 256 - G;
#pragma unroll
        for (int i = 0; i < KR / 2; ++i) { const unsigned lo0 = (u[2 * i] >> 16) == tauh ? (u[2 * i] & 0xffffu) : 0u, lo1 = (u[2 * i + 1] >> 16) == tauh ? (u[2 * i + 1] << 16) : 0u; pk[i] = lo0 | lo1; }
        unsigned taul = 0u; int g2 = ge - G;
#pragma unroll 1
        for (int bit = 15; bit >= 0 && g2 != need2; --bit) { const unsigned cand = taul | (1u << bit);
            const int cnt = count_ge16<KR / 2>(pk, cand);
            if (cnt >= need2) { taul = cand; g2 = cnt; } }
        tau |= taul; gefull = g2 == need2 ? 256 : 257;
    }
    unsigned long long myword = 0ull;
    tie_words<KR>(u, tau, gefull, t, lane, myword);
    return myword;
}

template <int R> __device__ __forceinline__ unsigned bp_rotl(unsigned x, int s) {
    if constexpr (R == 32) return __builtin_amdgcn_alignbit(x, x, (32 - s) & 31); else return ((x << s) | (x >> (R - s))) & ((1u << R) - 1u);
}
template <int R> __device__ __forceinline__ unsigned bp_rotr(unsigned x, int s) {
    if constexpr (R == 32) return __builtin_amdgcn_alignbit(x, x, s); else return ((x >> s) | (x << (R - s))) & ((1u << R) - 1u);
}
template <int R> __device__ __forceinline__ unsigned select_bp(const LAS float* Sq, int t, int lane) {
    constexpr int NC = R / 4, GB = R <= 8 ? 8 : (R <= 16 ? 16 : 32);
    const int rot = R == 32 ? ((lane >> 1) & 7) : (R == 16 ? ((lane >> 2) & 3) : ((lane >> 3) & 1));
    unsigned A[GB];
#pragma unroll
    for (int g = 0; g < NC; ++g) {
        int c = g + rot; if constexpr ((NC & (NC - 1)) != 0) c = c >= NC ? c - NC : c; else c &= NC - 1;
        const pg8::u32x4 v = *(const LAS pg8::u32x4*)(Sq + R * lane + 4 * c);
#pragma unroll
        for (int j = 0; j < 4; ++j) { const unsigned bits = v[j]; A[4 * g + j] = bits ^ ((unsigned)((int)bits >> 31) | 0x80000000u); }
    }
#pragma unroll
    for (int k = R; k < GB; ++k) A[k] = 0u;
#define BP_STAGE(J, M) _Pragma("unroll") for (int k = 0; k < GB; ++k) if ((k & (J)) == 0 && k + (J) < GB) { const unsigned lo = A[k], hi = A[k + (J)]; A[k] = (lo & (M)) | ((hi << (J)) & ~(M)); A[k + (J)] = ((lo >> (J)) & (M)) | (hi & ~(M)); }
    if constexpr (GB > 16) { BP_STAGE(16, 0x0000FFFFu) }
    if constexpr (GB > 8) { BP_STAGE(8, 0x00FF00FFu) }
    BP_STAGE(4, 0x0F0F0F0Fu) BP_STAGE(2, 0x33333333u) BP_STAGE(1, 0x55555555u)
#undef BP_STAGE
    constexpr unsigned MASKR = R == 32 ? ~0u : ((1u << (R & 31)) - 1u);
    const int nv = t + 1 - R * lane;
    const unsigned vmn = nv >= R ? MASKR : (nv <= 0 ? 0u : ((1u << (nv & 31)) - 1u));
    unsigned alive = bp_rotr<R>(vmn, 4 * rot), sel = 0u;
    int need = 256, cnt = t + 1;
#define BP_STEP(b) { unsigned pb; if constexpr (GB == 32) pb = A[(b)]; else pb = (A[(b) & (GB - 1)] >> (GB * ((b) / GB))) & ((1u << (GB & 31)) - 1u); \
        const unsigned ones = alive & pb; const int c = wave_sum_dpp(__popc(ones)); \
        unsigned nm; asm("s_cmp_ge_i32 %1, %2\n\ts_cselect_b32 %0, 0, -1" : "=s"(nm) : "s"(c), "s"(need) : "scc");     \
        alive &= pb ^ nm; sel |= ones & nm; { const int d = (int)((unsigned)c & nm); cnt = (int)(((unsigned)c & ~nm) | ((unsigned)(cnt - c) & nm)); need -= d; } }
#define BP_STEP4(b) BP_STEP(b) BP_STEP((b) - 1) BP_STEP((b) - 2) BP_STEP((b) - 3)
    BP_STEP4(31) BP_STEP4(27) BP_STEP4(23) BP_STEP4(19)
    if (cnt != need) { BP_STEP4(15)
        if (cnt != need) { BP_STEP4(11)
            if (cnt != need) { BP_STEP4(7)
                if (cnt != need) { BP_STEP4(3) } } } }
#undef BP_STEP4
#undef BP_STEP
    if (cnt != need) {
        const unsigned an = bp_rotl<R>(alive, 4 * rot); const int p = __popc(an); int x = p;
#pragma unroll 1
        for (int d = 1; d < 64; d <<= 1) { const int v = __shfl_up(x, d); if (lane >= d) x += v; }
        int take = need - (x - p); take = take < 0 ? 0 : (take > p ? p : take);
        unsigned m = an, r = 0u;
#pragma unroll 1
        for (int i = 0; i < take; ++i) { const unsigned lb = m & (0u - m); r |= lb; m ^= lb; }
        return bp_rotl<R>(sel, 4 * rot) | r;
    }
    return bp_rotl<R>(sel | alive, 4 * rot);
}
template <int R> __device__ __forceinline__ void store_sel(unsigned long long* MASKT, int b, int t, int lane, unsigned S) {
    if constexpr (R == 32) ((unsigned*)MASKT)[(((size_t)b * 32 + (lane >> 1)) * T + t) * 2 + (lane & 1)] = S;
    else if constexpr (R == 16) ((unsigned short*)MASKT)[(((size_t)b * 32 + (lane >> 2)) * T + t) * 4 + (lane & 3)] = (unsigned short)S;
    else if constexpr (R == 8) ((unsigned char*)MASKT)[(((size_t)b * 32 + (lane >> 3)) * T + t) * 8 + (lane & 7)] = (unsigned char)S;
    else {
#pragma unroll
        for (int i = 0; i < 3; ++i) { const int B = 3 * lane + i; ((unsigned char*)MASKT)[(((size_t)b * 32 + (B >> 3)) * T + t) * 8 + (B & 7)] = (unsigned char)(S >> (8 * i)); }
    }
    if constexpr (R < 32) { if (lane >= R && lane < 32) MASKT[((size_t)b * 32 + lane) * T + t] = 0ull; }
}

constexpr int DSA_S_OFF = 0;
__device__ __forceinline__ void indexer_unit(const bf16* QIDX, const bf16* KIDX, const float* WIDX, size_t tokb, int t0, LAS float* Sdst, int wave, int lane) {
    const int c = lane & 31, hi = lane >> 5;
    bf16x8 aq[4]; const int qq = c >> 2, hh = c & 3;
#pragma unroll
    for (int ks = 0; ks < 4; ++ks) aq[ks] = *(const bf16x8*)(QIDX + (tokb + t0 + qq) * 256 + hh * 64 + 16 * ks + 8 * hi);
    f32x4 wq[4];
#pragma unroll
    for (int jj = 0; jj < 4; ++jj) wq[jj] = *(const f32x4*)(WIDX + (tokb + t0 + 2 * jj + hi) * 4);
    const int ntiles = (t0 + 8 + 31) >> 5;
    const bf16* kb = KIDX + tokb * 64 + (size_t)hi * 256 + c * 8;
    bf16x8 kf[4], kn[4];
    if (wave < ntiles) {
#pragma unroll
        for (int ks = 0; ks < 4; ++ks) kf[ks] = *(const bf16x8*)(kb + (size_t)wave * 2048 + 512 * ks);
    }
#pragma unroll 1
    for (int tile = wave; tile < ntiles; tile += NWAVES) {
        const bool more = tile + NWAVES < ntiles;
        if (more) {
#pragma unroll
            for (int ks = 0; ks < 4; ++ks) kn[ks] = *(const bf16x8*)(kb + (size_t)(tile + NWAVES) * 2048 + 512 * ks);
        }
        f32x16 acc = {};
#pragma unroll
        for (int ks = 0; ks < 4; ++ks) acc = __builtin_amdgcn_mfma_f32_32x32x16_bf16(aq[ks], kf[ks], acc, 0, 0, 0);
        const int key = 32 * tile + c;
#pragma unroll
        for (int jj = 0; jj < 4; ++jj) { float sc = 0.f;
#pragma unroll
            for (int h = 0; h < 4; ++h) sc += wq[jj][h] * fmaxf(acc[4 * jj + h], 0.f);
            Sdst[(2 * jj + hi) * 2048 + key] = sc; }
        if (more) {
#pragma unroll
            for (int ks = 0; ks < 4; ++ks) kf[ks] = kn[ks];
        }
    }
}
constexpr int IDX_PRE = 6;
struct IdxRegs { bf16x8 aq[4]; f32x4 wq[4]; bf16x8 kf[IDX_PRE][4]; };
__device__ __forceinline__ void indexer_issue(const bf16* QIDX, const bf16* KIDX, const float* WIDX, size_t tokb, int t0, int wave, int lane, IdxRegs& r) {
    const int c = lane & 31, hi = lane >> 5, qq = c >> 2, hh = c & 3;
#pragma unroll
    for (int ks = 0; ks < 4; ++ks) r.aq[ks] = *(const bf16x8*)(QIDX + (tokb + t0 + qq) * 256 + hh * 64 + 16 * ks + 8 * hi);
#pragma unroll
    for (int jj = 0; jj < 4; ++jj) r.wq[jj] = *(const f32x4*)(WIDX + (tokb + t0 + 2 * jj + hi) * 4);
    const int ntiles = (t0 + 8 + 31) >> 5;
    const bf16* kb = KIDX + tokb * 64 + (size_t)hi * 256 + c * 8;
#pragma unroll
    for (int i = 0; i < IDX_PRE; ++i) { const int tile = wave + NWAVES * i;
        if (tile < ntiles) {
#pragma unroll
            for (int ks = 0; ks < 4; ++ks) r.kf[i][ks] = *(const bf16x8*)(kb + (size_t)tile * 2048 + 512 * ks); } }
}
__device__ __forceinline__ void indexer_tile(const IdxRegs& r, const bf16x8 (&kf)[4], int tile, LAS float* Sdst, int c, int hi) {
    f32x16 acc = {};
#pragma unroll
    for (int ks = 0; ks < 4; ++ks) acc = __builtin_amdgcn_mfma_f32_32x32x16_bf16(r.aq[ks], kf[ks], acc, 0, 0, 0);
    const int key = 32 * tile + c;
#pragma unroll
    for (int jj = 0; jj < 4; ++jj) { float sc = 0.f;
#pragma unroll
        for (int h = 0; h < 4; ++h) sc += r.wq[jj][h] * fmaxf(acc[4 * jj + h], 0.f);
        Sdst[(2 * jj + hi) * 2048 + key] = sc; }
}
__device__ __forceinline__ void indexer_compute(const IdxRegs& r, const bf16* KIDX, size_t tokb, int t0, LAS float* Sdst, int wave, int lane) {
    const int c = lane & 31, hi = lane >> 5;
    const int ntiles = (t0 + 8 + 31) >> 5;
    if constexpr (IDX_PRE < 8) if (ntiles > NWAVES * IDX_PRE) {
        const bf16* kb = KIDX + tokb * 64 + (size_t)hi * 256 + c * 8;
        bf16x8 k2[IDX_PRE < 8 ? 8 - IDX_PRE : 1][4];
#pragma unroll
        for (int i = IDX_PRE; i < 8; ++i) { const int tile = wave + NWAVES * i;
#pragma unroll
            for (int ks = 0; ks < 4; ++ks) k2[i - IDX_PRE][ks] = *(const bf16x8*)(kb + (size_t)tile * 2048 + 512 * ks); }
#pragma unroll
        for (int i = 0; i < IDX_PRE; ++i) indexer_tile(r, r.kf[i], wave + NWAVES * i, Sdst, c, hi);
#pragma unroll
        for (int i = IDX_PRE; i < 8; ++i) { const int tile = wave + NWAVES * i; if (tile < ntiles) indexer_tile(r, k2[i - IDX_PRE], tile, Sdst, c, hi); }
        return;
    }
    {
#pragma unroll
        for (int i = 0; i < IDX_PRE; ++i) { const int tile = wave + NWAVES * i; if (tile < ntiles) indexer_tile(r, r.kf[i], tile, Sdst, c, hi); }
    }
}
__device__ __forceinline__ void select_phase(Frame& F, const int mode) {
    { int t_ = F.wave0 * 64 + mk_lane(); asm volatile("" : "+v"(t_)); F.tid = t_; F.lane = t_ & 63; F.wave = __builtin_amdgcn_readfirstlane(t_ >> 6); }
    const int lane = F.lane, wave = F.wave;
    const bf16* QIDX = (const bf16*)(F.ws + WS_QIDX); const bf16* KIDX = (const bf16*)(F.ws + WS_KIDX); const float* WIDX = (const float*)(F.ws + WS_WIDX);
    unsigned long long* MASKT = (unsigned long long*)(F.ws + WS_MASKT);
    LAS float* S = (LAS float*)(F.lds + DSA_S_OFF);
    const int nunits = NB * (T / 8);
#define SEL_UNIT(u_, b_, t0_) const int b_ = (u_) >> 8; const int t0_ = ((((u_) & 255) + 16 * b_) & 255) * 8
    if (mode <= 1 && (int)blockIdx.x < nunits) { SEL_UNIT((int)blockIdx.x, b, t0); indexer_unit(QIDX, KIDX, WIDX, (size_t)b * T, t0, S, wave, lane); }
    __syncthreads();
    for (int i = 0; i * F.G + (int)blockIdx.x < nunits; ++i) {
        const int unit = i * F.G + (int)blockIdx.x;
#if MK_IDX_SPLIT
        int lane_u = F.lane; asm volatile("" : "+v"(lane_u));
        const bool has_next = mode <= 1 && unit + F.G < nunits;
        IdxRegs ir;
        if (has_next) { SEL_UNIT(unit + F.G, bn, t0n); indexer_issue(QIDX, KIDX, WIDX, (size_t)bn * T, t0n, wave, lane, ir); }
#else
        const bool idx_first = wave < 4;
        if (idx_first && mode <= 1 && unit + F.G < nunits) { SEL_UNIT(unit + F.G, bn, t0n); indexer_unit(QIDX, KIDX, WIDX, (size_t)bn * T, t0n, S + ((i + 1) & 1) * (8 * 2048), wave, lane); }
#endif
        SEL_UNIT(unit, b, t0);
        LAS float* Sw = S + (i & 1) * (8 * 2048) + wave * 2048;
        const int t = t0 + wave;
        unsigned long long myword = 0ull;
        if (mode != 1) {
#if MK_SEL_BP
        const bool st = (mode == 0 || mode == 3);
        const int lane = lane_u;
        if (t < 256) {
            if (lane < 32) { const int lo = 64 * lane; myword = t >= lo + 63 ? ~0ull : (t < lo ? 0ull : ((1ull << (t - lo + 1)) - 1ull)); if (st) MASKT[((size_t)b * 32 + lane) * T + t] = myword; }
        } else if (t < 512) { const unsigned Sb = select_bp<8>(Sw, t, lane); if (st) store_sel<8>(MASKT, b, t, lane, Sb); else asm volatile("" :: "v"(Sb)); }
        else if (t < 1024) { const unsigned Sb = select_bp<16>(Sw, t, lane); if (st) store_sel<16>(MASKT, b, t, lane, Sb); else asm volatile("" :: "v"(Sb)); }
        else if (t < 1536) { const unsigned Sb = select_bp<24>(Sw, t, lane); if (st) store_sel<24>(MASKT, b, t, lane, Sb); else asm volatile("" :: "v"(Sb)); }
        else { const unsigned Sb = select_bp<32>(Sw, t, lane); if (st) store_sel<32>(MASKT, b, t, lane, Sb); else asm volatile("" :: "v"(Sb)); }
#if MK_DEBUG
        { unsigned long long* MASKT2 = (unsigned long long*)(F.ws + WS_END); unsigned long long w2 = 0ull;
          if (t < 256) { if (lane < 32) { const int lo = 64 * lane; w2 = t >= lo + 63 ? ~0ull : (t < lo ? 0ull : ((1ull << (t - lo + 1)) - 1ull)); } }
          else if (t < 512) w2 = select_topk<8>(Sw, t, lane); else if (t < 1024) w2 = select_topk<16>(Sw, t, lane); else if (t < 1536) w2 = select_topk<24>(Sw, t, lane); else w2 = select_topk<32>(Sw, t, lane);
          if (lane < 32) MASKT2[((size_t)b * 32 + lane) * T + t] = w2; }
#endif
#else
        if (t < 256) {
            if (lane < 32) { const int lo = 64 * lane; myword = t >= lo + 63 ? ~0ull : (t < lo ? 0ull : ((1ull << (t - lo + 1)) - 1ull)); }
        } else if (t < 512) myword = select_topk<8>(Sw, t, lane);
        else if (t < 1024) myword = select_topk<16>(Sw, t, lane);
        else if (t < 1536) myword = select_topk<24>(Sw, t, lane);
        else myword = select_topk<32>(Sw, t, lane);
        if (mode == 2) asm volatile("" :: "v"(myword));
        if ((mode == 0 || mode == 3) && lane < 32) MASKT[((size_t)b * 32 + lane) * T + t] = myword;
#endif
        }
#if MK_IDX_SPLIT
        if (has_next) { SEL_UNIT(unit + F.G, bn2, t0n); indexer_compute(ir, KIDX, (size_t)bn2 * T, t0n, S + ((i + 1) & 1) * (8 * 2048), wave, lane); }
#else
        if (!idx_first && mode <= 1 && unit + F.G < nunits) { SEL_UNIT(unit + F.G, bn, t0n); indexer_unit(QIDX, KIDX, WIDX, (size_t)bn * T, t0n, S + ((i + 1) & 1) * (8 * 2048), wave, lane); }
#endif
        __syncthreads();
    }
#undef SEL_UNIT
}

constexpr int ATT_KB = 0, ATT_VB = 32768;
constexpr int ATT_LUT = 65536;
__device__ __forceinline__ float lane_half_max(float v) {
    const auto rr = __builtin_amdgcn_permlane32_swap(__builtin_bit_cast(unsigned, v), __builtin_bit_cast(unsigned, v), false, false);
    return fmaxf(__builtin_bit_cast(float, rr[0]), __builtin_bit_cast(float, rr[1]));
}
__device__ __forceinline__ void attn_phase(Frame& F) {
    int tid; { int t_ = F.wave0 * 64 + mk_lane(); asm volatile("" : "+v"(t_)); tid = t_; }
    const int lane = tid & 63, wave = __builtin_amdgcn_readfirstlane(tid >> 6), r32 = lane & 31, hi = lane >> 5;
    const bf16* Q = (const bf16*)(F.ws + WS_Q); const bf16* KP = (const bf16*)(F.ws + WS_KP); const bf16* VPT = (const bf16*)(F.ws + WS_VP);
    const unsigned long long* MASKT = (const unsigned long long*)(F.ws + WS_MASKT);
    bf16* ACT = (bf16*)(F.ws + WS_ACT);
    const int srow = tid >> 3, sch = tid & 7;
    const unsigned kdst = (unsigned)(srow * 128 + ((sch ^ ((srow >> 1) & 7)) << 4));
    const unsigned vdst0 = (unsigned)(srow * 128 + ((((sch >> 1) * 2) ^ ((srow >> 1) & 7)) << 4) + 8 * (sch & 1));
    const unsigned vdst1 = (unsigned)(srow * 128 + ((((sch >> 1) * 2 + 1) ^ ((srow >> 1) & 7)) << 4) + 8 * (sch & 1));
    const unsigned frow = (unsigned)(r32 * 128), fsw = (unsigned)((r32 >> 1) & 7);
    const int nunits = NB * 8 * 4;
    if (tid < 16) { const unsigned lo = ((tid & 1) ? 0xffffu : 0u) | ((tid & 2) ? 0xffff0000u : 0u), hi2 = ((tid & 4) ? 0xffffu : 0u) | ((tid & 8) ? 0xffff0000u : 0u);
        *(LAS unsigned long long*)(F.lds + ATT_LUT + 8 * tid) = (unsigned long long)lo | ((unsigned long long)hi2 << 32); }
    __syncthreads();
    for (int it = 0; ; ++it) {
        int bh, qb;
        if (F.G == 256) { if (it >= 2) break; bh = (int)blockIdx.x >> 1; qb = ((int)blockIdx.x & 1) ? (it == 0 ? 2 : 1) : (it == 0 ? 3 : 0); }
        else { const int uid = it * F.G + (int)blockIdx.x; if (uid >= nunits) break; bh = uid >> 2; qb = uid & 3; }
        const int b = bh >> 3, h = bh & 7, q0 = qb * 512; const size_t tokb = (size_t)b * T;
        const int qrowA = q0 + wave * 64 + r32;
        bf16x8 qf[2][4];
#pragma unroll
        for (int qq = 0; qq < 2; ++qq)
#pragma unroll
            for (int ks = 0; ks < 4; ++ks) qf[qq][ks] = *(const bf16x8*)((const char*)(Q + (tokb + q0 + wave * 64 + 32 * qq) * 512 + h * 64 + 16 * ks) + (unsigned)(r32 * 512 + 8 * hi) * 2u);
        f32x16 o[2][2]; o[0][0] = f32x16{}; o[0][1] = f32x16{}; o[1][0] = f32x16{}; o[1][1] = f32x16{};
        float m[2] = {0.f, 0.f}, l[2] = {0.f, 0.f};
        const int nst = 4 * (qb + 1), wlast = (q0 + wave * 64 + 63) >> 6;
        const char* kbase = (const char*)(KP + tokb * 512 + h * 64); const char* vbase = (const char*)(VPT + (size_t)(h * 64) * NT + tokb);
        const char* mbase = (const char*)(MASKT + (size_t)b * 32 * T + q0 + wave * 64);
        const unsigned klane = (unsigned)(srow * 512 + 8 * sch) * 2u, vlane = (unsigned)(srow * NT + 8 * sch) * 2u, mlane = (unsigned)r32 * 8u;
#define ATT_KLD(ko_) (*(const v4u*)(kbase + (size_t)(ko_) * 1024 + klane))
#define ATT_VLD(ko_) (*(const v4u*)(vbase + (size_t)(ko_) * 2 + vlane))
#define ATT_MLD(j_, q_) (*(const unsigned long long*)(mbase + ((size_t)(j_) * T + 32 * (q_)) * 8 + mlane))
        v4u kr0 = ATT_KLD(0), kr1 = ATT_KLD(64), vr0 = ATT_VLD(0), vr1 = ATT_VLD(64);
        unsigned long long mw[2][2];
        mw[0][0] = ATT_MLD(0, 0); mw[0][1] = ATT_MLD(0, 1); mw[1][0] = ATT_MLD(1, 0); mw[1][1] = ATT_MLD(1, 1);
#define ATT_STAGE_WRITE(boff_) do { \
        *(LAS v4u*)(F.lds + ATT_KB + (boff_) + kdst) = kr0; *(LAS v4u*)(F.lds + ATT_KB + (boff_) + 8192 + kdst) = kr1; \
        *(LAS unsigned long long*)(F.lds + ATT_VB + (boff_) + vdst0) = (unsigned long long)vr0.x | ((unsigned long long)vr0.y << 32); \
        *(LAS unsigned long long*)(F.lds + ATT_VB + (boff_) + vdst1) = (unsigned long long)vr0.z | ((unsigned long long)vr0.w << 32); \
        *(LAS unsigned long long*)(F.lds + ATT_VB + (boff_) + 8192 + vdst0) = (unsigned long long)vr1.x | ((unsigned long long)vr1.y << 32); \
        *(LAS unsigned long long*)(F.lds + ATT_VB + (boff_) + 8192 + vdst1) = (unsigned long long)vr1.z | ((unsigned long long)vr1.w << 32); } while (0)
        ATT_STAGE_WRITE(0u);
        __syncthreads();
#pragma unroll 1
        for (int st = 0; st < nst; ++st) {
            const unsigned boff = (unsigned)(st & 1) * 16384u;
#if MK_ATT_SKEW
            if (wave >= 4) __builtin_amdgcn_s_sleep(MK_ATT_SKEW);
#endif
            unsigned long long mn[2][2] = {{0ull, 0ull}, {0ull, 0ull}};
            if (st + 1 < nst) { const size_t ko = (size_t)(st + 1) * 128;
                kr0 = ATT_KLD(ko); kr1 = ATT_KLD(ko + 64); vr0 = ATT_VLD(ko); vr1 = ATT_VLD(ko + 64);
                mn[0][0] = ATT_MLD(2 * st + 2, 0); mn[0][1] = ATT_MLD(2 * st + 2, 1); mn[1][0] = ATT_MLD(2 * st + 3, 0); mn[1][1] = ATT_MLD(2 * st + 3, 1); }
#pragma unroll
            for (int sub = 0; sub < 2; ++sub) {
                const int j = 2 * st + sub;
                if (j <= wlast) {
                    const unsigned so = boff + (unsigned)sub * 8192u;
                    f32x16 p[2][2]; p[0][0] = f32x16{}; p[0][1] = f32x16{}; p[1][0] = f32x16{}; p[1][1] = f32x16{};
#pragma unroll
                    for (int ks = 0; ks < 4; ++ks) {
                        const unsigned ch = (((unsigned)(2 * ks + hi)) ^ fsw) << 4;
                        const bf16x8 k0 = *(const LAS bf16x8*)(F.lds + ATT_KB + so + frow + ch), k1 = *(const LAS bf16x8*)(F.lds + ATT_KB + so + frow + 4096 + ch);
#pragma unroll
                        for (int qq = 0; qq < 2; ++qq) { p[qq][0] = __builtin_amdgcn_mfma_f32_32x32x16_bf16(k0, qf[qq][ks], p[qq][0], 0, 0, 0); p[qq][1] = __builtin_amdgcn_mfma_f32_32x32x16_bf16(k1, qf[qq][ks], p[qq][1], 0, 0, 0); }
                    }
#pragma unroll
                    for (int qq = 0; qq < 2; ++qq) {
                        const float mold = m[qq];
#pragma unroll
                        for (int r = 0; r < 16; ++r) { p[qq][0][r] -= mold; p[qq][1][r] -= mold; }
                        float mx = fmaxf(p[qq][0][0], p[qq][1][0]);
#pragma unroll
                        for (int r = 1; r < 16; ++r) mx = fmaxf(mx, fmaxf(p[qq][0][r], p[qq][1][r]));
                        mx = lane_half_max(mx);
                        if (j == 0 || __any(mx > ATT_THR)) {
                            const float dl = j == 0 ? mx : fmaxf(mx, 0.f), al = __builtin_amdgcn_exp2f(-dl);
                            m[qq] += dl; l[qq] *= al;
#pragma unroll
                            for (int r = 0; r < 16; ++r) { o[qq][0][r] *= al; o[qq][1][r] *= al; p[qq][0][r] -= dl; p[qq][1][r] -= dl; }
                        }
#pragma unroll
                        for (int r = 0; r < 16; ++r) { p[qq][0][r] = __builtin_amdgcn_exp2f(p[qq][0][r]); p[qq][1][r] = __builtin_amdgcn_exp2f(p[qq][1][r]); }
                    }
#pragma unroll
                    for (int s = 0; s < 4; ++s) {
                        const unsigned ch = (((unsigned)(2 * s + hi)) ^ fsw) << 4;
                        const bf16x8 v0 = *(const LAS bf16x8*)(F.lds + ATT_VB + so + frow + ch), v1 = *(const LAS bf16x8*)(F.lds + ATT_VB + so + frow + 4096 + ch);
#pragma unroll
                        for (int qq = 0; qq < 2; ++qq) {
                            v4u pw; const int hb = s >> 1, s2 = s & 1;
                            const unsigned m3 = (((unsigned)(mw[sub][qq] >> (32 * hb + 4 * hi))) & 0x0f0f0f0fu) << 3;
                            const unsigned long long pm0 = *(const LAS unsigned long long*)(F.lds + ATT_LUT + __builtin_amdgcn_ubfe(m3, 16 * s2, 7)), pm1 = *(const LAS unsigned long long*)(F.lds + ATT_LUT + __builtin_amdgcn_ubfe(m3, 16 * s2 + 8, 7));
                            pw.x = pg8::cvt_pk_bf16(p[qq][hb][8 * s2 + 0], p[qq][hb][8 * s2 + 1]) & (unsigned)pm0; pw.y = pg8::cvt_pk_bf16(p[qq][hb][8 * s2 + 2], p[qq][hb][8 * s2 + 3]) & (unsigned)(pm0 >> 32);
                            pw.z = pg8::cvt_pk_bf16(p[qq][hb][8 * s2 + 4], p[qq][hb][8 * s2 + 5]) & (unsigned)pm1; pw.w = pg8::cvt_pk_bf16(p[qq][hb][8 * s2 + 6], p[qq][hb][8 * s2 + 7]) & (unsigned)(pm1 >> 32);
                            l[qq] = dot2_ones(pw.x, l[qq]); l[qq] = dot2_ones(pw.y, l[qq]); l[qq] = dot2_ones(pw.z, l[qq]); l[qq] = dot2_ones(pw.w, l[qq]);
                            const bf16x8 pf = __builtin_bit_cast(bf16x8, pw);
                            o[qq][0] = __builtin_amdgcn_mfma_f32_32x32x16_bf16(v0, pf, o[qq][0], 0, 0, 0);
                            o[qq][1] = __builtin_amdgcn_mfma_f32_32x32x16_bf16(v1, pf, o[qq][1], 0, 0, 0);
                        }
                        __builtin_amdgcn_sched_barrier(0);
                    }
                }
            }
            if (st + 1 < nst) { const unsigned nb = (unsigned)((st + 1) & 1) * 16384u; ATT_STAGE_WRITE(nb); }
#pragma unroll
            for (int a = 0; a < 2; ++a)
#pragma unroll
                for (int c = 0; c < 2; ++c) mw[a][c] = mn[a][c];
            __syncthreads();
        }
#undef ATT_STAGE_WRITE
#undef ATT_KLD
#undef ATT_VLD
#undef ATT_MLD
#pragma unroll
        for (int qq = 0; qq < 2; ++qq) {
            float lt = l[qq]; lt += __shfl_xor(lt, 32);
            const float rl = 1.0f / lt;
            int lo_ = lane; asm volatile("" : "+v"(lo_));
            bf16* orow = (bf16*)((char*)(ACT + (tokb + q0 + wave * 64 + 32 * qq) * 1536 + h * 64) + (unsigned)((lo_ & 31) * 1536 + 4 * (lo_ >> 5)) * 2u);
#pragma unroll
            for (int g4 = 0; g4 < 4; ++g4) {
                *(unsigned long long*)(orow + 8 * g4) = (unsigned long long)pk2(o[qq][0][4 * g4] * rl, o[qq][0][4 * g4 + 1] * rl) | ((unsigned long long)pk2(o[qq][0][4 * g4 + 2] * rl, o[qq][0][4 * g4 + 3] * rl) << 32);
                *(unsigned long long*)(orow + 32 + 8 * g4) = (unsigned long long)pk2(o[qq][1][4 * g4] * rl, o[qq][1][4 * g4 + 1] * rl) | ((unsigned long long)pk2(o[qq][1][4 * g4 + 2] * rl, o[qq][1][4 * g4 + 3] * rl) << 32);
            }
        }
    }
}

constexpr int N_PHASES = 15;
struct Args { const float* in[31]; float* out; unsigned char* ws; int ph_lo, ph_hi; };
__global__ void __launch_bounds__(NWAVES * 64, 2) mk_fwd(Args args) {
    extern __shared__ __attribute__((aligned(16))) unsigned char lds[];
    Frame F;
    F.lds = (LAS unsigned char*)lds;
    F.tid = threadIdx.x; F.lane = F.tid & 63; F.wave = __builtin_amdgcn_readfirstlane(F.tid >> 6); F.wave0 = F.wave; F.G = gridDim.x;
#pragma unroll
    for (int i = 0; i < 31; ++i) F.in[i] = args.in[i];
    F.out = args.out; F.ws = args.ws;
    unsigned char* ws = args.ws;
    for (int u = F.tid; u < (LDS_BYTES - LDSCTL_OFF) / 4; u += NWAVES * 64) ((LAS unsigned*)(F.lds + LDSCTL_OFF))[u] = 0u;
    __syncthreads();
#if MK_ONE_LAUNCH
    cooperative_groups::grid_group grid = cooperative_groups::this_grid();
    XcdBarrier bar = xcd_barrier_post((unsigned*)(ws + WS_CTL) + CW_BAR, (volatile LAS unsigned*)(F.lds + MISC_OFF) + 8, (unsigned)F.wave0);
    if (args.ph_lo < 0) grid.sync();
#define SEAM(k) do { xcd_barrier(bar); } while (0)
#else
#define SEAM(k) do { } while (0)
#endif
    const int lo = args.ph_lo, hi = args.ph_hi;
#define IN(k) ((((MK_PHMASK) >> (k)) & 1) && lo <= (k) && (k) < hi)
#define BOTH(k) (IN(k) && IN((k) + 1))
    typedef pg8::bf16_t bt;
    bt* H = (bt*)(ws + WS_H); bt* Y = (bt*)(ws + WS_Y); bt* HID = (bt*)(ws + WS_BIG); bt* ACT = (bt*)(ws + WS_ACT);
    bf16* X1B = (bf16*)F.out;
    bf16* X2B = (bf16*)(ws + WS_ACT);
    const int bid = (int)blockIdx.x;

#define REPS(k) ((k) == MK_REP_PHASE ? 2 : 1)
    if (IN(0)) { for (int rep = 0; rep < REPS(0); ++rep) { p0_prologue(F); if (rep + 1 < REPS(0)) SEAM(0); } if (BOTH(0)) SEAM(0); }
    if (IN(1)) { for (int rep = 0; rep < REPS(1); ++rep) {
        { pg8::Gemm g{H, (const bt*)(ws + WS_WGU1), NT, 5632, 1024, 1024, 1024}; g.w0 = F.wave0; pg8::StaticOrder S; S.init(NT, 5632, F.G, bid); pg8::EpiSwiglu E{HID, FF};
          pg8::gemm_phase<pg8::EpiSwiglu, pg8::StaticOrder, MK_ALIGN, MK_SP2>(F.lds, g, S, E); }
        if (rep + 1 < REPS(1)) SEAM(1); } if (BOTH(1)) SEAM(1);
    }
    if (IN(2)) { for (int rep = 0; rep < REPS(2); ++rep) {
        pg8::Gemm g{HID, (const bt*)(ws + WS_WDN1), NT, 1024, FF, FF, FF}; g.w0 = F.wave0; pg8::StaticOrder S; S.init(NT, 1024, F.G, bid); pg8::EpiSplit E{Y, 1024, 1 << 20, nullptr, 0, 1.f, 1.f};
        pg8::gemm_phase<pg8::EpiSplit, pg8::StaticOrder, MK_ALIGN, MK_SP2>(F.lds, g, S, E);
        if (rep + 1 < REPS(2)) SEAM(2); } if (BOTH(2)) SEAM(2);
    }
    if (IN(3)) { for (int rep = 0; rep < REPS(3); ++rep) { ew_phase<false, true>(F, (const bf16*)Y, F.in[0], F.in[3], 0.5f, X1B, (bf16*)H); if (rep + 1 < REPS(3)) SEAM(3); } if (BOTH(3)) SEAM(3); }
    if (IN(4)) { for (int rep = 0; rep < REPS(4); ++rep) {
        pg8::Gemm g{H, (const bt*)(ws + WS_WIN), NT, 2304, 1024, 1024, 1024}; g.w0 = F.wave0; pg8::StaticOrder S; S.init(NT, 2304, F.G, bid);
        pg8::EpiWinA E{(bt*)(ws + WS_CQ), (bt*)(ws + WS_CKV), (float*)(ws + WS_KW), Y, Y + (size_t)NT * 512, F.in[10], 0.08838834764831845f * LOG2E, (PG8_LAS float*)(F.lds + RED_OFF)};
        pg8::gemm_phase<pg8::EpiWinA, pg8::StaticOrder, true, MK_SP2>(F.lds, g, S, E);
        { const int cm = F.G == 256 ? bid - 128 : bid;
          if (cm >= 0 && cm < 32) { pg8::Gemm g{(const bt*)(ws + WS_MEMN), (const bt*)(ws + WS_WMK), NB * NMEM, 512, 1024, 1024, 1024}; g.w0 = F.wave0; pg8::StaticOrder S; S.init(NB * NMEM, 512, 1 << 20, cm);
            pg8::EpiSplit E{(bt*)(ws + WS_MK), 512, 1 << 20, nullptr, 0, 1.f, 1.f}; pg8::gemm_phase<pg8::EpiSplit, pg8::StaticOrder, MK_ALIGN, MK_SP2>(F.lds, g, S, E); }
          const int cv = F.G == 256 ? bid - 160 : bid - 32;
          if (cv >= 0 && cv < 32) { pg8::Gemm g{(const bt*)(ws + WS_WMV), (const bt*)(ws + WS_MEMN), 512, NB * NMEM, 1024, 1024, 1024}; g.w0 = F.wave0; pg8::StaticOrder S; S.init(512, NB * NMEM, 1 << 20, cv);
            pg8::EpiSplit E{(bt*)(ws + WS_MVT), NB * NMEM, 1 << 20, nullptr, 0, 1.f, 1.f}; pg8::gemm_phase<pg8::EpiSplit, pg8::StaticOrder, MK_ALIGN, MK_SP2>(F.lds, g, S, E); } }
        if (rep + 1 < REPS(4)) SEAM(4); } if (BOTH(4)) SEAM(4);
    }
    if (IN(5)) { for (int rep = 0; rep < REPS(5); ++rep) { const int p5m = rep == 0 ? MK_P5MASK : MK_REP_MODE;
        if (p5m & 1) { pg8::Gemm g{(const bt*)(ws + WS_CQ), (const bt*)(ws + WS_WQ), NT, 768, 256, 256, 256}; g.w0 = F.wave0; pg8::StaticOrder S; S.init(NT, 768, F.G, bid);
          pg8::EpiSplit E{(bt*)(ws + WS_Q), 512, 2, (bt*)(ws + WS_QIDX), 256, 1.f, 1.f}; pg8::gemm_phase<pg8::EpiSplit, pg8::StaticOrder, MK_ALIGN, MK_SP2>(F.lds, g, S, E); }
        if (p5m & 2) { pg8::Gemm g{(const bt*)(ws + WS_CKV), (const bt*)(ws + WS_WKV), NT, 512, 256, 256, 256}; g.w0 = F.wave0; pg8::StaticOrder S; S.init(NT, 512, F.G, bid);
          pg8::EpiSplit E{(bt*)(ws + WS_KP), 512, 1 << 20, nullptr, 0, 1.f, 1.f}; pg8::gemm_phase<pg8::EpiSplit, pg8::StaticOrder, MK_ALIGN, MK_SP2>(F.lds, g, S, E); }
        if (p5m & 2) { pg8::Gemm g{(const bt*)(ws + WS_WKV) + (size_t)512 * 256, (const bt*)(ws + WS_CKV), 512, NT, 256, 256, 256}; g.w0 = F.wave0; pg8::StaticOrder S; S.init(512, NT, F.G, bid);
          pg8::EpiSplit E{(bt*)(ws + WS_VP), NT, 1 << 20, nullptr, 0, 1.f, 1.f}; pg8::gemm_phase<pg8::EpiSplit, pg8::StaticOrder, MK_ALIGN, MK_SP2>(F.lds, g, S, E); }
        if (p5m & 4) kidx_phase(F);
        if (p5m & 8) conv_phase(F);
        if (p5m & 16) memattn_phase(F);
        if (rep + 1 < REPS(5)) SEAM(5); } if (BOTH(5)) SEAM(5);
    }
    if (IN(6)) { for (int rep = 0; rep < REPS(6); ++rep) { select_phase(F, rep == 0 ? 0 : MK_REP_MODE); if (rep + 1 < REPS(6)) SEAM(6); } if (BOTH(6)) SEAM(6); }
    if (IN(7)) { for (int rep = 0; rep < REPS(7); ++rep) { attn_phase(F); if (rep + 1 < REPS(7)) SEAM(7); } if (BOTH(7)) SEAM(7); }
    if (IN(8)) { for (int rep = 0; rep < REPS(8); ++rep) {
        pg8::Gemm g{H, (const bt*)(ws + WS_WIN) + (size_t)2304 * 1024, NT, 3072, 1024, 1024, 1024}; g.w0 = F.wave0; pg8::StaticOrder S; S.init(NT, 3072, F.G, bid); pg8::EpiGates E{HID, 3072};
        pg8::gemm_phase<pg8::EpiGates, pg8::StaticOrder, MK_ALIGN, MK_SP2>(F.lds, g, S, E);
        if (rep + 1 < REPS(8)) SEAM(8); } if (BOTH(8)) SEAM(8);
    }
    if (IN(9)) { for (int rep = 0; rep < REPS(9); ++rep) {
        pg8::Gemm g{ACT, (const bt*)(ws + WS_WCAT), NT, 1024, 512, 1536, 1536}; g.w0 = F.wave0; pg8::MergeOrder S; S.base.init(NT, 1024, F.G, bid); pg8::EpiMerge E{HID, H};
        pg8::gemm_phase<pg8::EpiMerge, pg8::MergeOrder, MK_ALIGN, MK_SP2>(F.lds, g, S, E);
        if (rep + 1 < REPS(9)) SEAM(9); } if (BOTH(9)) SEAM(9);
    }
    if (IN(10)) { for (int rep = 0; rep < REPS(10); ++rep) {
        pg8::Gemm g{H, (const bt*)(ws + WS_WOUT), NT, 1024, 1024, 1024, 1024}; g.w0 = F.wave0; pg8::StaticOrder S; S.init(NT, 1024, F.G, bid); pg8::EpiSplit E{Y, 1024, 1 << 20, nullptr, 0, 1.f, 1.f};
        pg8::gemm_phase<pg8::EpiSplit, pg8::StaticOrder, MK_ALIGN, MK_SP2>(F.lds, g, S, E);
        if (rep + 1 < REPS(10)) SEAM(10); } if (BOTH(10)) SEAM(10);
    }
    if (IN(11)) { for (int rep = 0; rep < REPS(11); ++rep) { ew_phase<true, true>(F, (const bf16*)Y, X1B, F.in[7], 1.0f, X2B, (bf16*)H); if (rep + 1 < REPS(11)) SEAM(11); } if (BOTH(11)) SEAM(11); }
    if (IN(12)) { for (int rep = 0; rep < REPS(12); ++rep) {
        pg8::Gemm g{H, (const bt*)(ws + WS_WGU2), NT, 5632, 1024, 1024, 1024}; g.w0 = F.wave0; pg8::StaticOrder S; S.init(NT, 5632, F.G, bid); pg8::EpiSwiglu E{HID, FF};
        pg8::gemm_phase<pg8::EpiSwiglu, pg8::StaticOrder, MK_ALIGN, MK_SP2>(F.lds, g, S, E);
        if (rep + 1 < REPS(12)) SEAM(12); } if (BOTH(12)) SEAM(12);
    }
    if (IN(13)) { for (int rep = 0; rep < REPS(13); ++rep) {
        pg8::Gemm g{HID, (const bt*)(ws + WS_WDN2), NT, 1024, FF, FF, FF}; g.w0 = F.wave0; pg8::StaticOrder S; S.init(NT, 1024, F.G, bid); pg8::EpiSplit E{Y, 1024, 1 << 20, nullptr, 0, 1.f, 1.f};
        pg8::gemm_phase<pg8::EpiSplit, pg8::StaticOrder, MK_ALIGN, MK_SP2>(F.lds, g, S, E);
        if (rep + 1 < REPS(13)) SEAM(13); } if (BOTH(13)) SEAM(13);
    }
    if (IN(14)) { ew_phase<true, false>(F, (const bf16*)Y, X2B, F.in[28], 0.5f, F.out, nullptr); }
#undef IN
#undef BOTH
}

#if MK_DEBUG
constexpr int DBG_W = 2048;
__device__ __forceinline__ float blk_sum(float v, float* sh) {
    v = wave_sum(v); __syncthreads(); if ((threadIdx.x & 63) == 0) sh[threadIdx.x >> 6] = v; __syncthreads();
    float t = 0.f; for (int i = 0; i < 8; ++i) t += sh[i]; __syncthreads(); return t;
}
__device__ __forceinline__ void dbg_report(unsigned char* ws, int slot, float err2, float ref2) {
    if (threadIdx.x == 0) { const float rel = sqrtf(err2 / fmaxf(ref2, 1e-30f)); atomicMax((unsigned*)ws + DBG_W + slot, __builtin_bit_cast(unsigned, rel)); if (rel > 0.03f) atomicAdd((unsigned*)ws + DBG_W + 8 + slot, 1u); }
}
__device__ __forceinline__ int dbg_row(int i) { return (int)(((unsigned)i * 2654435761u) % (unsigned)NT); }
__global__ void __launch_bounds__(512) dbg_ffn(const float* xin, const float* gpre, const float* wgu, const float* wdn, const unsigned short* Y, unsigned char* ws, int slot) {
    __shared__ float h[1024]; __shared__ float hid[2816]; __shared__ float sh[8];
    const int r = dbg_row(blockIdx.x), tid = threadIdx.x;
    float s = 0.f; for (int k = tid; k < 1024; k += 512) { const float v = xin[(size_t)r * 1024 + k]; s += v * v; }
    s = blk_sum(s, sh); const float rstd = 1.0f / sqrtf(s / 1024.f + 1e-6f);
    for (int k = tid; k < 1024; k += 512) h[k] = xin[(size_t)r * 1024 + k] * rstd * gpre[k];
    __syncthreads();
    for (int j = tid; j < 2816; j += 512) { float g = 0.f, u = 0.f; for (int k = 0; k < 1024; ++k) { g += h[k] * wgu[(size_t)k * 5632 + j]; u += h[k] * wgu[(size_t)k * 5632 + 2816 + j]; }
        hid[j] = g / (1.f + expf(-g)) * u; }
    __syncthreads();
    float e2 = 0.f, r2 = 0.f;
    for (int n = tid; n < 1024; n += 512) { float y = 0.f; for (int j = 0; j < 2816; ++j) y += hid[j] * wdn[(size_t)j * 1024 + n];
        const float d = y - bf2f(Y[(size_t)r * 1024 + n]); e2 += d * d; r2 += y * y; }
    e2 = blk_sum(e2, sh); r2 = blk_sum(r2, sh); dbg_report(ws, slot, e2, r2);
}
__global__ void __launch_bounds__(512) dbg_ew(const float* xin, const unsigned short* Y, const float* gain, float coef, const float* xout, const unsigned short* H, unsigned char* ws, int slot) {
    __shared__ float sh[8];
    const int r = dbg_row(blockIdx.x), tid = threadIdx.x;
    float s = 0.f; for (int k = tid; k < 1024; k += 512) { const float v = bf2f(Y[(size_t)r * 1024 + k]); s += v * v; }
    s = blk_sum(s, sh); const float rstd = 1.0f / sqrtf(s / 1024.f + 1e-6f);
    float xn[2]; float s2 = 0.f; float e2 = 0.f, r2 = 0.f;
    for (int i = 0; i < 2; ++i) { const int k = tid + 512 * i; xn[i] = xin[(size_t)r * 1024 + k] + coef * gain[k] * bf2f(Y[(size_t)r * 1024 + k]) * rstd; s2 += xn[i] * xn[i];
        const float d = xn[i] - xout[(size_t)r * 1024 + k]; e2 += d * d; r2 += xn[i] * xn[i]; }
    s2 = blk_sum(s2, sh); const float r2d = 1.0f / sqrtf(s2 / 1024.f + 1e-6f);
    if (H) for (int i = 0; i < 2; ++i) { const int k = tid + 512 * i; const float hv = xn[i] * r2d; const float d = hv - bf2f(H[(size_t)r * 1024 + k]); e2 += d * d; r2 += hv * hv; }
    e2 = blk_sum(e2, sh); r2 = blk_sum(r2, sh); dbg_report(ws, slot, e2, r2);
}
__global__ void __launch_bounds__(512) dbg_conv(const unsigned short* H, const float* gpre, const float* win, const float* wdw, const float* bdw, const float* lng, const float* lnb, const unsigned short* ACT, unsigned char* ws, int slot) {
    __shared__ float hrow[1024]; __shared__ float sh[8];
    const int t = dbg_row(blockIdx.x), tid = threadIdx.x, tb = t % T;
    float y = bdw[tid];
    for (int j = 0; j < 31; ++j) { const int p = tb - 30 + j; if (p < 0) continue;
        const int s = t - 30 + j;
        __syncthreads();
        for (int k = tid; k < 1024; k += 512) hrow[k] = bf2f(H[(size_t)s * 1024 + k]) * gpre[k];
        __syncthreads();
        float a = 0.f, g = 0.f; for (int k = 0; k < 1024; ++k) { a += hrow[k] * win[(size_t)k * 5188 + 580 + tid]; g += hrow[k] * win[(size_t)k * 5188 + 1092 + tid]; }
        y += wdw[j * 512 + tid] * (a / (1.f + expf(-g))); }
    const float mean = blk_sum(y, sh) / 512.f; const float xc = y - mean; const float var = blk_sum(xc * xc, sh) / 512.f;
    float v = xc / sqrtf(var + 1e-6f) * lng[tid] + lnb[tid]; v = v / (1.f + expf(-v));
    const float d = v - bf2f(ACT[(size_t)t * 1536 + 512 + tid]);
    const float e2 = blk_sum(d * d, sh), r2 = blk_sum(v * v, sh); dbg_report(ws, slot, e2, r2);
}

__global__ void __launch_bounds__(512) dbg_merge(const unsigned short* ACT, const unsigned short* G, const float* wa, const float* wb, const float* wm, const unsigned short* Hm, unsigned char* ws, int slot) {
    __shared__ float arow[1536]; __shared__ float sh[8];
    const int r = dbg_row(blockIdx.x), tid = threadIdx.x;
    for (int k = tid; k < 1536; k += 512) arow[k] = bf2f(ACT[(size_t)r * 1536 + k]);
    __syncthreads();
    float e2 = 0.f, r2 = 0.f;
    for (int n = tid; n < 1024; n += 512) { float ya = 0.f, yb = 0.f, ym = 0.f;
        for (int k = 0; k < 512; ++k) { ya += arow[k] * wa[(size_t)k * 1024 + n]; yb += arow[512 + k] * wb[(size_t)k * 1024 + n]; ym += arow[1024 + k] * wm[(size_t)k * 1024 + n]; }
        const float v = bf2f(G[(size_t)r * 3072 + n]) * ya + bf2f(G[(size_t)r * 3072 + 1024 + n]) * yb + bf2f(G[(size_t)r * 3072 + 2048 + n]) * ym;
        const float d = v - bf2f(Hm[(size_t)r * 1024 + n]); e2 += d * d; r2 += v * v; }
    e2 = blk_sum(e2, sh); r2 = blk_sum(r2, sh); dbg_report(ws, slot, e2, r2);
}
__global__ void __launch_bounds__(512) dbg_gemm(const unsigned short* A, int K, const float* W, const unsigned short* O, unsigned char* ws, int slot) {
    __shared__ float arow[2816]; __shared__ float sh[8];
    const int r = dbg_row(blockIdx.x), tid = threadIdx.x;
    for (int k = tid; k < K; k += 512) arow[k] = bf2f(A[(size_t)r * K + k]);
    __syncthreads();
    float e2 = 0.f, r2 = 0.f;
    for (int n = tid; n < 1024; n += 512) { float y = 0.f; for (int k = 0; k < K; ++k) y += arow[k] * W[(size_t)k * 1024 + n];
        const float d = y - bf2f(O[(size_t)r * 1024 + n]); e2 += d * d; r2 += y * y; }
    e2 = blk_sum(e2, sh); r2 = blk_sum(r2, sh); dbg_report(ws, slot, e2, r2);
}
__global__ void dbg_force(unsigned char* ws, int slot) { if (threadIdx.x == 0 && blockIdx.x == 0) ((unsigned*)ws)[DBG_W + slot] = __builtin_bit_cast(unsigned, 1.0f); }

__global__ void __launch_bounds__(512) dbg_lin(const unsigned short* A, int lda, int K, const float* ascale, const float* W, int ldw, int coff, int N, const unsigned short* O, long o_rs, long o_cs, float oscale, int act, int nrows, unsigned char* ws, int slot) {
    __shared__ float arow[1024]; __shared__ float sh[8];
    const int r = (int)(((unsigned)blockIdx.x * 2654435761u) % (unsigned)nrows), tid = threadIdx.x;
    for (int k = tid; k < K; k += 512) arow[k] = bf2f(A[(size_t)r * lda + k]) * (ascale ? ascale[k] : 1.f);
    __syncthreads();
    float e2 = 0.f, r2 = 0.f;
    for (int n = tid; n < N; n += 512) { float y = 0.f; for (int k = 0; k < K; ++k) y += arow[k] * W[(size_t)k * ldw + coff + n];
        y *= oscale; if (act == 1) y = 1.f / (1.f + expf(-y));
        const float dd = y - bf2f(O[(size_t)r * o_rs + (size_t)n * o_cs]); e2 += dd * dd; r2 += y * y; }
    e2 = blk_sum(e2, sh); r2 = blk_sum(r2, sh); dbg_report(ws, slot, e2, r2);
    if (threadIdx.x == 0 && sqrtf(e2 / fmaxf(r2, 1e-30f)) > 0.03f) atomicAdd((unsigned*)ws + DBG_W + 16 + ((r % T) < 256 ? 0 : 1), 1u);
}
__global__ void __launch_bounds__(512) dbg_rms256(const unsigned short* Hh, const float* gpre, const float* win, int coff, const float* gain, const unsigned short* O, unsigned char* ws, int slot) {
    __shared__ float arow[1024]; __shared__ float sh[8];
    const int r = dbg_row(blockIdx.x), tid = threadIdx.x;
    for (int k = tid; k < 1024; k += 512) arow[k] = bf2f(Hh[(size_t)r * 1024 + k]) * gpre[k];
    __syncthreads();
    float z = 0.f; if (tid < 256) for (int k = 0; k < 1024; ++k) z += arow[k] * win[(size_t)k * 5188 + coff + tid];
    const float ss = blk_sum(z * z, sh); const float rstd = 1.0f / sqrtf(ss / 256.f + 1e-6f);
    float e = 0.f, rr = 0.f; if (tid < 256) { const float v = z * rstd * (gain ? gain[tid] : 1.f); const float dd = v - bf2f(O[(size_t)r * 256 + tid]); e = dd * dd; rr = v * v; }
    e = blk_sum(e, sh); rr = blk_sum(rr, sh); dbg_report(ws, slot, e, rr);
}
__global__ void __launch_bounds__(512) dbg_kidx(const unsigned short* Hh, const float* gpre, const float* win, const float* lg, const float* lb, const unsigned short* KIDX, const float* WIDX, unsigned char* ws, int slot) {
    __shared__ float arow[1024]; __shared__ float sh[8];
    const int r = dbg_row(blockIdx.x), tid = threadIdx.x;
    for (int k = tid; k < 1024; k += 512) arow[k] = bf2f(Hh[(size_t)r * 1024 + k]) * gpre[k];
    __syncthreads();
    float z = 0.f; if (tid < 68) for (int k = 0; k < 1024; ++k) z += arow[k] * win[(size_t)k * 5188 + 512 + tid];
    const float mean = blk_sum(tid < 64 ? z : 0.f, sh) / 64.f; const float xc = tid < 64 ? z - mean : 0.f; const float var = blk_sum(xc * xc, sh) / 64.f;
    float e = 0.f, rr = 0.f;
    if (tid < 64) { const float v = xc / sqrtf(var + 1e-6f) * lg[tid] + lb[tid]; const float dd = v - bf2f(KIDX[(size_t)r * 64 + tid]); e = dd * dd; rr = v * v; }
    else if (tid < 68) { const float v = z * 0.5f; const float dd = v - WIDX[(size_t)r * 4 + tid - 64]; e = dd * dd; rr = v * v; }
    e = blk_sum(e, sh); rr = blk_sum(rr, sh); dbg_report(ws, slot, e, rr);
}
__global__ void __launch_bounds__(512) dbg_memattn(const unsigned short* QM, const unsigned short* MK, const unsigned short* MVT, const unsigned short* ACT, unsigned char* ws, int slot) {
    __shared__ float s[4][256]; __shared__ float sh[8];
    const int tok = dbg_row(blockIdx.x), tid = threadIdx.x, b = tok / T, h = tid >> 7, dcol = tid & 127;
    for (int i = 0; i < 2; ++i) { const int idx = tid + 512 * i, hh = idx >> 8, m = idx & 255; float a = 0.f;
        for (int dd = 0; dd < 128; ++dd) a += bf2f(QM[(size_t)tok * 512 + hh * 128 + dd]) * bf2f(MK[(size_t)(b * 256 + m) * 512 + hh * 128 + dd]);
        s[hh][m] = a; }
    __syncthreads();
    float mx = -INFINITY; for (int m = 0; m < 256; ++m) mx = fmaxf(mx, s[h][m]);
    float l = 0.f, o = 0.f; for (int m = 0; m < 256; ++m) { const float p = exp2f(s[h][m] - mx); l += p; o += p * bf2f(MVT[(size_t)(h * 128 + dcol) * (NB * 256) + b * 256 + m]); }
    o /= l; const float dd = o - bf2f(ACT[(size_t)tok * 1536 + 1024 + tid]);
    const float e = blk_sum(dd * dd, sh), rr = blk_sum(o * o, sh); dbg_report(ws, slot, e, rr);
}
__global__ void __launch_bounds__(512) dbg_dsa(const unsigned short* Q, const unsigned short* KP, const unsigned short* VP, const unsigned short* QIDX, const unsigned short* KIDX, const float* WIDX, const unsigned short* ACT, unsigned char* ws, int slot) {
    __shared__ float sc[2048]; __shared__ unsigned char selflag[2048]; __shared__ float sh[8];
    const int tok = dbg_row(blockIdx.x), tid = threadIdx.x, b = tok / T, t = tok % T; const size_t tokb = (size_t)b * T;
    for (int key = tid; key <= t; key += 512) { float tot = 0.f;
        for (int hh = 0; hh < 4; ++hh) { float a = 0.f; for (int dd = 0; dd < 64; ++dd) a += bf2f(QIDX[(size_t)tok * 256 + hh * 64 + dd]) * bf2f(KIDX[(tokb + key) * 64 + dd]); tot += WIDX[(size_t)tok * 4 + hh] * fmaxf(a, 0.f); }
        sc[key] = tot; }
    __syncthreads();
    for (int key = tid; key <= t; key += 512) { int rank = 0; const float v = sc[key]; for (int k2 = 0; k2 <= t; ++k2) { const float w = sc[k2]; rank += (w > v || (w == v && k2 < key)) ? 1 : 0; } selflag[key] = rank < 256 ? 1 : 0; }
    __syncthreads();
    const int h = tid >> 6; float mx = -INFINITY, l = 0.f, o = 0.f;
    for (int key = 0; key <= t; ++key) { if (!selflag[key]) continue; float a = 0.f;
        for (int dd = 0; dd < 64; ++dd) a += bf2f(Q[(size_t)tok * 512 + h * 64 + dd]) * bf2f(KP[(tokb + key) * 512 + h * 64 + dd]);
        const float mn = fmaxf(mx, a), f = expf(mx - mn), p = expf(a - mn); l = l * f + p; o = o * f + p * bf2f(VP[(tokb + key) * 512 + tid]); mx = mn; }
    o /= l; const float dd = o - bf2f(ACT[(size_t)tok * 1536 + tid]);
    const float e = blk_sum(dd * dd, sh), rr = blk_sum(o * o, sh); dbg_report(ws, slot, e, rr);
}

__global__ void __launch_bounds__(512) dbg_lin_t(const unsigned short* A, int K, const unsigned short* WT, int N, const unsigned short* O, int ldo, int act, unsigned char* ws, int slot) {
    __shared__ float arow[1024]; __shared__ float sh[8];
    const int r = dbg_row(blockIdx.x), tid = threadIdx.x;
    for (int k = tid; k < K; k += 512) arow[k] = bf2f(A[(size_t)r * K + k]);
    __syncthreads();
    float e2 = 0.f, r2 = 0.f;
    for (int n = tid; n < N; n += 512) { float y = 0.f; for (int k = 0; k < K; ++k) y += arow[k] * bf2f(WT[(size_t)n * K + k]);
        if (act == 1) y = 1.f / (1.f + expf(-y));
        const float dd = y - bf2f(O[(size_t)r * ldo + n]); e2 += dd * dd; r2 += y * y; }
    e2 = blk_sum(e2, sh); r2 = blk_sum(r2, sh); dbg_report(ws, slot, e2, r2);
}
__global__ void __launch_bounds__(512) dbg_wt(const unsigned short* WT, int K, const float* W, int ldw, int coff, const float* gsc, unsigned char* ws, int slot) {
    __shared__ float sh[8];
    const int n = blockIdx.x, tid = threadIdx.x; float e2 = 0.f, r2 = 0.f;
    for (int k = tid; k < K; k += 512) { const float v = W[(size_t)k * ldw + coff + n] * (gsc ? gsc[k] : 1.f); const float dd = v - bf2f(WT[(size_t)n * K + k]); e2 += dd * dd; r2 += v * v; }
    e2 = blk_sum(e2, sh); r2 = blk_sum(r2, sh); dbg_report(ws, slot, e2, r2);
}

__global__ void __launch_bounds__(256) dbg_tile(const unsigned short* A, const unsigned short* WT, const unsigned short* O, unsigned char* ws) {
    __shared__ float arow[1024]; __shared__ float sh2[4]; __shared__ float sh3[4];
    const int r = dbg_row(blockIdx.x / 12), pn = blockIdx.x % 12, tid = threadIdx.x, n = pn * 256 + tid;
    for (int k = tid; k < 1024; k += 256) arow[k] = bf2f(A[(size_t)r * 1024 + k]);
    __syncthreads();
    float y = 0.f; for (int k = 0; k < 1024; ++k) y += arow[k] * bf2f(WT[(size_t)n * 1024 + k]);
    if (MK_DBG_SIG) y = 1.f / (1.f + expf(-y));
    const float dd = y - bf2f(O[(size_t)r * 3072 + n]);
    float e2 = wave_sum(dd * dd), r2 = wave_sum(y * y);
    if ((tid & 63) == 0) { sh2[tid >> 6] = e2; sh3[tid >> 6] = r2; }
    __syncthreads();
    if (tid == 0) { e2 = sh2[0] + sh2[1] + sh2[2] + sh2[3]; r2 = sh3[0] + sh3[1] + sh3[2] + sh3[3];
        if (sqrtf(e2 / r2) > 0.03f) { const int pm = r / 256; int fi = 7;
            for (int c = 0; c < 256; ++c) { pg8::StaticOrder S; S.init(NT, 3072, 256, c); pg8::Unit u; for (int i = 0; S.next(i, u); ++i) if (u.pm == pm && u.pn == pn) fi = i; }
            atomicAdd((unsigned*)ws + DBG_W + 24 + fi, 1u); atomicAdd((unsigned*)ws + DBG_W + 23, 1u); } }
}

__global__ void __launch_bounds__(256) dbg_gates_naive(const unsigned short* A, const unsigned short* WT, unsigned short* O) {
    __shared__ float arow[8][1024];
    const int r0 = (blockIdx.x / 12) * 8, n = (blockIdx.x % 12) * 256 + threadIdx.x;
    for (int i = threadIdx.x; i < 8 * 1024; i += 256) arow[i >> 10][i & 1023] = bf2f(A[(size_t)(r0 + (i >> 10)) * 1024 + (i & 1023)]);
    __syncthreads();
    float acc[8] = {0.f, 0.f, 0.f, 0.f, 0.f, 0.f, 0.f, 0.f};
    const v4u* wp = (const v4u*)(WT + (size_t)n * 1024);
    for (int k8 = 0; k8 < 128; ++k8) { const v4u w = wp[k8];
#pragma unroll
        for (int e = 0; e < 4; ++e) { const float w0 = pg8::bf_lo(w[e]), w1 = pg8::bf_hi(w[e]);
#pragma unroll
            for (int i = 0; i < 8; ++i) acc[i] += arow[i][8 * k8 + 2 * e] * w0 + arow[i][8 * k8 + 2 * e + 1] * w1; } }
#pragma unroll
    for (int i = 0; i < 8; ++i) O[(size_t)(r0 + i) * 3072 + n] = (unsigned short)f2bf(1.f / (1.f + expf(-acc[i])));
}
__global__ void dbg_cmp_mask(const unsigned long long* a, const unsigned long long* b2, unsigned char* ws) {
    const size_t n = (size_t)NB * 32 * T; unsigned bad = 0u, nz = 0u;
    for (size_t i = (size_t)blockIdx.x * blockDim.x + threadIdx.x; i < n; i += (size_t)gridDim.x * blockDim.x) { if (a[i] != b2[i]) ++bad; if (b2[i] != 0ull) ++nz; }
    if (bad) atomicAdd((unsigned*)ws + DBG_W + 23, bad);
    if (nz) atomicAdd((unsigned*)ws + DBG_W + 22, nz);
}
__global__ void dbg_apply(float* out, const unsigned char* ws, float t0, float t1, float t2, float t3) {
    const unsigned* w = (const unsigned*)ws + DBG_W; float delta = 0.f;
    if (MK_SEL_BP) { delta += 0.02f; if (w[22] < 100000u) delta += 0.4f; }
    if (w[23] > 0u) delta += 0.1f; if (w[23] > 100u) delta += 0.2f; if (w[23] > 1228u) delta += 0.4f;
    const size_t n = (size_t)NT * D; for (size_t i = (size_t)blockIdx.x * blockDim.x + threadIdx.x; i < n; i += (size_t)gridDim.x * blockDim.x) out[i] *= (1.f + delta);
}
#endif

extern "C" void kernel_launch(void* const* d_in, const int* in_sizes, int n_in, void* d_out, int out_size, void* d_ws, size_t ws_size, hipStream_t stream) {
    static int grid = 0;
    if (grid == 0) {
        if (n_in != 31 || out_size != NT * D || ws_size < WS_END) { fprintf(stderr, "kernel_launch: unexpected problem (n_in %d out %d ws %zu)\n", n_in, out_size, ws_size); grid = -1; return; }
        int dev = 0, cus = 0, per_cu = 0;
        if (hipGetDevice(&dev) != hipSuccess || hipDeviceGetAttribute(&cus, hipDeviceAttributeMultiprocessorCount, dev) != hipSuccess) { grid = -1; return; }
        if (hipFuncSetAttribute((const void*)mk_fwd, hipFuncAttributeMaxDynamicSharedMemorySize, LDS_BYTES) != hipSuccess) { fprintf(stderr, "kernel_launch: hipFuncSetAttribute failed\n"); grid = -1; return; }
        if (hipOccupancyMaxActiveBlocksPerMultiprocessor(&per_cu, (const void*)mk_fwd, NWAVES * 64, LDS_BYTES) != hipSuccess || per_cu < 1) { fprintf(stderr, "kernel_launch: occupancy query says %d\n", per_cu); per_cu = 1; }
        (void)hipGetLastError();
        grid = cus;
        if (grid != 256) fprintf(stderr, "kernel_launch: note: %d CUs\n", grid);
    }
    if (grid < 0) return;
    (void)hipMemsetAsync((char*)d_ws + WS_CTL, 0, CTL_ZERO_BYTES, stream);
    Args a{};
    for (int i = 0; i < 31; ++i) a.in[i] = (const float*)d_in[i];
    a.out = (float*)d_out; a.ws = (unsigned char*)d_ws;
#if MK_ONE_LAUNCH
    a.ph_lo = 0; a.ph_hi = N_PHASES;
    void* kargs[] = {&a};
    hipError_t e = hipLaunchCooperativeKernel((const void*)mk_fwd, dim3(grid), dim3(NWAVES * 64), kargs, LDS_BYTES, stream);
    if (e != hipSuccess) fprintf(stderr, "kernel_launch: cooperative launch failed: %s\n", hipGetErrorString(e));
#else
    for (int p = 0; p < N_PHASES; ++p) { a.ph_lo = p; a.ph_hi = p + 1; hipLaunchKernelGGL(mk_fwd, dim3(grid), dim3(NWAVES * 64), LDS_BYTES, stream, a);
#if MK_DEBUG
        unsigned char* ws = (unsigned char*)d_ws; const float* const* in = (const float* const*)a.in;
        typedef const unsigned short* cus;
        if (p == 6 && MK_SEL_BP) hipLaunchKernelGGL(dbg_cmp_mask, dim3(1024), dim3(256), 0, stream, (const unsigned long long*)(ws + WS_MASKT), (const unsigned long long*)(ws + WS_END), ws);
        if (p == 7 && !MK_SEL_BP) hipLaunchKernelGGL(dbg_tile, dim3(2048 * 12), dim3(256), 0, stream, (cus)(ws + WS_H), (cus)(ws + WS_WIN) + (size_t)2304 * 1024, (cus)(ws + WS_BIG), ws);
        if (p == N_PHASES - 1) hipLaunchKernelGGL(dbg_apply, dim3(1024), dim3(256), 0, stream, (float*)d_out, ws, 0.03f, 0.03f, 0.03f, 0.03f);
#endif
    }
#endif
}
```

```cpp
#include <hip/hip_runtime.h>
#include <hip/hip_cooperative_groups.h>
#include <cstdio>
#include <cstdint>
#include <cmath>
#ifndef MK_ONE_LAUNCH
#define MK_ONE_LAUNCH 1
#endif
#ifndef MK_PHMASK
#define MK_PHMASK 0x7fff
#endif
#ifndef MK_P5MASK
#define MK_P5MASK 31
#endif
#ifndef MK_ZERO_DSA
#define MK_ZERO_DSA 0
#endif
#ifndef MK_ZERO_MEM
#define MK_ZERO_MEM 0
#endif
#ifndef MK_DEBUG
#define MK_DEBUG 0
#endif
#ifndef MK_DBG_SIG
#define MK_DBG_SIG 1
#endif
#ifndef MK_REP_PHASE
#define MK_REP_PHASE -1
#endif
#ifndef MK_REP_MODE
#define MK_REP_MODE 0
#endif
#ifndef MK_SP2
#define MK_SP2 true
#endif
#ifndef MK_ALIGN
#define MK_ALIGN true
#endif

#define MK_WT_STORE 3
#define MK_SEL_BP 1
#define MK_IDX_SPLIT 1
#define MK_ATT_SKEW 0
#define MK_PRIO_MERGE 1
__device__ __forceinline__ int mk_lane() { int l; asm volatile("v_mbcnt_lo_u32_b32 %0, -1, 0\n\tv_mbcnt_hi_u32_b32 %0, -1, %0" : "=v"(l)); return l; }
namespace pg8 {
#define PG8_LAS __attribute__((address_space(3)))
typedef unsigned short bf16_t;
typedef short bf16x8 __attribute__((ext_vector_type(8)));
typedef float f32x4 __attribute__((ext_vector_type(4)));
typedef unsigned u32x4 __attribute__((ext_vector_type(4)));
constexpr int BM = 256, BK = 64, HALF = 128, HTB = HALF * BK * 2  , STAGE_BYTES = 8 * HTB, NXCD = 8, WGM = 8;

__host__ __device__ __forceinline__ int lds_byte(int r, int c) { const int st = (r >> 4) * 2 + (c >> 5), rr = r & 15, cc = c & 31, ob = rr * 64 + cc * 2; return st * 1024 + (ob ^ (((ob >> 9) & 1) << 5)); }
__host__ __device__ __forceinline__ void stage_rc(int b, int& R, int& C) { const int st = b / 1024, sb = b % 1024, swz = sb ^ (((sb >> 9) & 1) << 5); R = (st >> 1) * 16 + swz / 64; C = (st & 1) * 32 + (swz % 64) / 2; }
__host__ __device__ __forceinline__ int perm32(int rho) { const int n = rho >> 4, i = rho & 15; return 8 * (i >> 2) + 4 * n + (i & 3); }

struct Unit { int pm, pn, seg; };
struct Gemm { const bf16_t* A; const bf16_t* Bt; int M, N, K, lda, ldb; int w0 = 0; };

struct StaticOrder {
    int nM, nN, nwg, G, c;
    __host__ __device__ void init(int M, int N, int G_, int c_) { nM = M / BM; nN = N / BM; nwg = nM * nN; G = G_; c = c_; }
    __host__ __device__ bool next(int i, Unit& u) const {
        const long L = (long)i * G + c; if (L >= nwg) return false;
        int wgid = (int)L; { const int q = nwg / NXCD, r = nwg % NXCD, xcd = wgid % NXCD, off = wgid / NXCD; wgid = (xcd < r ? xcd * (q + 1) : r * (q + 1) + (xcd - r) * q) + off; }
        const int nig = WGM * nN, gid = wgid / nig, fm = gid * WGM, gsz = (nM - fm) < WGM ? (nM - fm) : WGM;
        u.pm = fm + ((wgid % nig) % gsz); u.pn = (wgid % nig) / gsz; u.seg = 0; return true;
    }
    __device__ __forceinline__ void a_ready(const Unit&) const {}
    __device__ __forceinline__ void done(const Unit&) const {}
};
typedef float f32x2_cv __attribute__((ext_vector_type(2))); typedef __bf16 bf16x2_cv __attribute__((ext_vector_type(2)));
__device__ __forceinline__ unsigned cvt_pk_bf16(float lo, float hi) { const f32x2_cv v = {lo, hi}; return __builtin_bit_cast(unsigned, __builtin_convertvector(v, bf16x2_cv)); }
typedef float f32x2 __attribute__((ext_vector_type(2)));
template <class Epi, class Sched, bool ALIGN_EPI = false, bool SP2 = false>
__device__ __forceinline__ void gemm_phase(PG8_LAS unsigned char* lds, const Gemm g, const Sched& S, const Epi& E) {
    int tid_ = g.w0 * 64 + mk_lane(); asm volatile("" : "+v"(tid_));
    const int tid = tid_, wid = __builtin_amdgcn_readfirstlane(tid >> 6), lane = tid & 63, wr = wid >> 2, wc = wid & 3, fr = lane & 15, fq = lane >> 4;
    const int K = g.K, nt = K / BK;
    unsigned voffA[2], voffB[2];
#pragma unroll
    for (int i = 0; i < 2; ++i) { int R, C; stage_rc(tid * 16 + i * 8192, R, C); const int Rb = Epi::PERM ? ((R & ~31) + perm32(R & 31)) : R;
        voffA[i] = (unsigned)(R * g.lda + C) * 2u; voffB[i] = (unsigned)(Rb * g.ldb + C) * 2u; }
    const size_t kstep = (size_t)(BK * 2);
    const size_t hstepB = (size_t)HALF * g.ldb * 2, hstepA = (size_t)HALF * g.lda * 2;
    const size_t tstepB = 2 * hstepB, tstepA = 2 * hstepA;
    const unsigned ldsw = (unsigned)wid * 1024u;
    const int aoff = lds_byte(wr * 64 + fr, fq * 8), boff = lds_byte(wc * 32 + fr, fq * 8);
#define PG8_SA(b, h) (((b) * 2 + (h)) * HTB)
#define PG8_SB(b, h) ((4 + (b) * 2 + (h)) * HTB)
#define PG8_STAGE(bufoff, gbase, voff) do { _Pragma("unroll") for (int _i = 0; _i < 2; ++_i) \
        __builtin_amdgcn_global_load_lds((const unsigned*)((const char*)(gbase) + (voff)[_i]), (PG8_LAS unsigned*)(lds + (bufoff) + ldsw + _i * 8192), 16, 0, 0); } while (0)
#define PG8_LDA(dst, b, h) do { _Pragma("unroll") for (int m = 0; m < 4; ++m) _Pragma("unroll") for (int k = 0; k < 2; ++k) dst[m][k] = *(const PG8_LAS bf16x8*)(lds + PG8_SA(b, h) + aoff + m * 2048 + k * 1024); } while (0)
#define PG8_LDB(dst, b, h) do { _Pragma("unroll") for (int n = 0; n < 2; ++n) _Pragma("unroll") for (int k = 0; k < 2; ++k) dst[n][k] = *(const PG8_LAS bf16x8*)(lds + PG8_SB(b, h) + boff + n * 2048 + k * 1024); } while (0)
#define PG8_MMA(ai, bj, At, Bt) do { __builtin_amdgcn_s_setprio(1); _Pragma("unroll") for (int m = 0; m < 4; ++m) _Pragma("unroll") for (int n = 0; n < 2; ++n) _Pragma("unroll") for (int k = 0; k < 2; ++k) \
        acc[ai][bj][m][n] = __builtin_amdgcn_mfma_f32_16x16x32_bf16(Bt[n][k], At[m][k], acc[ai][bj][m][n], 0, 0, 0); __builtin_amdgcn_s_setprio(0); } while (0)
#define PG8_MMA_NP(ai, bj, At, Bt) do { _Pragma("unroll") for (int m = 0; m < 4; ++m) _Pragma("unroll") for (int n = 0; n < 2; ++n) _Pragma("unroll") for (int k = 0; k < 2; ++k) \
        acc[ai][bj][m][n] = __builtin_amdgcn_mfma_f32_16x16x32_bf16(Bt[n][k], At[m][k], acc[ai][bj][m][n], 0, 0, 0); } while (0)
#if MK_PRIO_MERGE
#define PG8_MMA2(a0, b0, a1, b1) do { __builtin_amdgcn_s_setprio(1); PG8_MMA_NP(a0, b0, At, B0); PG8_MMA_NP(a1, b1, At, B1); __builtin_amdgcn_s_setprio(0); } while (0)
#else
#define PG8_MMA2(a0, b0, a1, b1) do { PG8_MMA(a0, b0, At, B0); PG8_MMA(a1, b1, At, B1); } while (0)
#endif
#define PG8_WAIT_V(n) asm volatile("s_waitcnt vmcnt(" #n ")" ::: "memory")
#define PG8_WAIT_L(n) asm volatile("s_waitcnt lgkmcnt(" #n ")" ::: "memory")
#define PG8_BAR __builtin_amdgcn_s_barrier()
#define PG8_SCHED __builtin_amdgcn_sched_barrier(0)
    Unit cur, nxt; int ui = 0;
    if (!S.next(0, cur)) return;
    f32x4 acc[2][2][4][2];
#pragma unroll
    for (int a = 0; a < 2; ++a)
#pragma unroll
        for (int b = 0; b < 2; ++b)
#pragma unroll
            for (int m = 0; m < 4; ++m)
#pragma unroll
                for (int n = 0; n < 2; ++n) acc[a][b][m][n] = (f32x4){0.f, 0.f, 0.f, 0.f};
    bf16x8 At[4][2], B0[2][2], B1[2][2];
    const char* cA = (const char*)g.A + (size_t)cur.pm * tstepA + E.koff(cur); const char* cB = (const char*)g.Bt + (size_t)cur.pn * tstepB + E.koff(cur);
    S.a_ready(cur);
    if constexpr (SP2) {
        PG8_STAGE(PG8_SB(0, 0), cB, voffB); PG8_STAGE(PG8_SB(0, 1), cB + hstepB, voffB); PG8_STAGE(PG8_SA(0, 0), cA, voffA); PG8_STAGE(PG8_SA(0, 1), cA + hstepA, voffA);
        if (wr == 1) PG8_BAR;
        PG8_WAIT_V(2); PG8_BAR;
        PG8_STAGE(PG8_SB(1, 0), cB + kstep, voffB); PG8_STAGE(PG8_SA(1, 0), cA + kstep, voffA); PG8_STAGE(PG8_SB(1, 1), cB + hstepB + kstep, voffB);
        PG8_WAIT_V(6); PG8_BAR;
    } else {
        PG8_STAGE(PG8_SB(0, 0), cB, voffB); PG8_STAGE(PG8_SA(0, 0), cA, voffA); PG8_STAGE(PG8_SB(0, 1), cB + hstepB, voffB); PG8_STAGE(PG8_SA(0, 1), cA + hstepA, voffA);
        if (wr == 1) PG8_BAR;
        PG8_WAIT_V(4); PG8_BAR;
        PG8_STAGE(PG8_SB(1, 0), cB + kstep, voffB); PG8_STAGE(PG8_SA(1, 0), cA + kstep, voffA); PG8_STAGE(PG8_SB(1, 1), cB + hstepB + kstep, voffB);
        PG8_WAIT_V(6); PG8_BAR;
    }
    for (;;) {
        const bool has_next = S.next(ui + 1, nxt);
        const char* nA = has_next ? (const char*)g.A + (size_t)nxt.pm * tstepA + E.koff(nxt) : cA; const char* nB = has_next ? (const char*)g.Bt + (size_t)nxt.pn * tstepB + E.koff(nxt) : cB;
        for (int t = 0; t < nt; t += 2) {
            if constexpr (Epi::HAS_MID) E.mid(acc, cur, t, wr, wc, fr, fq);
            const bool last = (t == nt - 2);
            const char* a1 = cA + (size_t)(t + 1) * kstep;
            const char* a2 = last ? nA : cA + (size_t)(t + 2) * kstep; const char* b2 = last ? nB : cB + (size_t)(t + 2) * kstep;
            const char* a3 = a2 + kstep; const char* b3 = b2 + kstep;
            if (last && has_next) S.a_ready(nxt);
            if constexpr (SP2) {
            PG8_LDB(B0, 0, 0); PG8_LDB(B1, 0, 1); PG8_SCHED; PG8_LDA(At, 0, 0); PG8_STAGE(PG8_SA(1, 1), a1 + hstepA, voffA);
            PG8_WAIT_V(8); PG8_WAIT_L(0); PG8_BAR; PG8_MMA2(0, 0, 0, 1); PG8_BAR; PG8_SCHED;
            PG8_LDA(At, 0, 1); PG8_STAGE(PG8_SB(0, 0), b2, voffB); PG8_STAGE(PG8_SB(0, 1), b2 + hstepB, voffB); PG8_STAGE(PG8_SA(0, 0), a2, voffA);
            PG8_WAIT_V(8); PG8_WAIT_L(0); PG8_BAR; PG8_MMA2(1, 0, 1, 1); PG8_BAR; PG8_SCHED;
            PG8_LDB(B0, 1, 0); PG8_LDB(B1, 1, 1); PG8_SCHED; PG8_LDA(At, 1, 0); PG8_STAGE(PG8_SA(0, 1), a2 + hstepA, voffA);
            PG8_WAIT_V(8); PG8_WAIT_L(0); PG8_BAR; PG8_MMA2(0, 0, 0, 1); PG8_BAR; PG8_SCHED;
            PG8_LDA(At, 1, 1); PG8_STAGE(PG8_SB(1, 0), b3, voffB); PG8_STAGE(PG8_SB(1, 1), b3 + hstepB, voffB); PG8_STAGE(PG8_SA(1, 0), a3, voffA);
            PG8_WAIT_V(8); PG8_WAIT_L(0); PG8_BAR; PG8_MMA2(1, 0, 1, 1); PG8_BAR; PG8_SCHED;
            } else {
            PG8_LDB(B0, 0, 0); PG8_SCHED; PG8_LDA(At, 0, 0); PG8_STAGE(PG8_SA(1, 1), a1 + hstepA, voffA);
            PG8_WAIT_L(8); PG8_BAR; PG8_WAIT_L(0); PG8_MMA(0, 0, At, B0); PG8_BAR; PG8_SCHED;
            PG8_LDB(B1, 0, 1); PG8_STAGE(PG8_SB(0, 0), b2, voffB);
            PG8_BAR; PG8_WAIT_L(0); PG8_MMA(0, 1, At, B1); PG8_BAR;
            PG8_LDA(At, 0, 1); PG8_STAGE(PG8_SA(0, 0), a2, voffA);
            PG8_BAR; PG8_WAIT_L(0); PG8_MMA(1, 0, At, B0); PG8_BAR; PG8_SCHED;
            PG8_STAGE(PG8_SB(0, 1), b2 + hstepB, voffB);
            PG8_WAIT_V(6); PG8_BAR; PG8_MMA(1, 1, At, B1); PG8_BAR;
            PG8_LDB(B0, 1, 0); PG8_SCHED; PG8_LDA(At, 1, 0); PG8_STAGE(PG8_SA(0, 1), a2 + hstepA, voffA);
            PG8_WAIT_L(8); PG8_BAR; PG8_WAIT_L(0); PG8_MMA(0, 0, At, B0); PG8_BAR; PG8_SCHED;
            PG8_LDB(B1, 1, 1); PG8_STAGE(PG8_SB(1, 0), b3, voffB);
            PG8_BAR; PG8_WAIT_L(0); PG8_MMA(0, 1, At, B1); PG8_BAR;
            PG8_LDA(At, 1, 1); PG8_STAGE(PG8_SA(1, 0), a3, voffA);
            PG8_BAR; PG8_WAIT_L(0); PG8_MMA(1, 0, At, B0); PG8_BAR; PG8_SCHED;
            PG8_STAGE(PG8_SB(1, 1), b3 + hstepB, voffB);
            PG8_WAIT_V(6); PG8_BAR; PG8_MMA(1, 1, At, B1); PG8_BAR;
            }
        }
        if constexpr (ALIGN_EPI) { if (wr == 0) PG8_BAR; }
        if constexpr (!Epi::AFTER_DRAIN) { E(acc, cur, wr, wc, fr, fq); S.done(cur); }
        if (!has_next) break;
        if (!E.keep(cur)) {
#pragma unroll
        for (int a = 0; a < 2; ++a)
#pragma unroll
            for (int b = 0; b < 2; ++b)
#pragma unroll
                for (int m = 0; m < 4; ++m)
#pragma unroll
                    for (int n = 0; n < 2; ++n) acc[a][b][m][n] = (f32x4){0.f, 0.f, 0.f, 0.f};
        }
        cur = nxt; cA = nA; cB = nB; ++ui;
        if constexpr (ALIGN_EPI) { if (wr == 1) PG8_BAR; }
    }
    PG8_WAIT_V(0);
    if constexpr (!ALIGN_EPI) { if (wr == 0) PG8_BAR; }
    PG8_BAR;
    if constexpr (Epi::AFTER_DRAIN) { E.fused(acc, cur, wr, wc, fr, fq, lds, wid, lane); S.done(cur); }
#undef PG8_SA
#undef PG8_SB
#undef PG8_STAGE
#undef PG8_LDA
#undef PG8_LDB
#undef PG8_MMA
#undef PG8_MMA_NP
#undef PG8_MMA2
#undef PG8_WAIT_V
#undef PG8_WAIT_L
#undef PG8_BAR
#undef PG8_SCHED
}
}

#define GAS __attribute__((address_space(1)))
#define LAS __attribute__((address_space(3)))
typedef unsigned short bf16;
typedef unsigned v4u __attribute__((ext_vector_type(4)));
typedef float f32x4 __attribute__((ext_vector_type(4)));
typedef short bf16x8 __attribute__((ext_vector_type(8)));
typedef GAS unsigned gu32;
typedef GAS unsigned long long gu64;
#define RLX_AGENT __ATOMIC_RELAXED, __HIP_MEMORY_SCOPE_AGENT
#define LDS_WAIT() asm volatile("s_waitcnt lgkmcnt(0)" ::: "memory")
#define VM_WAIT() asm volatile("s_waitcnt vmcnt(0)" ::: "memory")
__device__ __forceinline__ unsigned long long rt() { return __builtin_amdgcn_s_memrealtime(); }
__device__ __forceinline__ unsigned f2bf(float f) { unsigned u = __builtin_bit_cast(unsigned, f); return (u + 0x7fffu + ((u >> 16) & 1u)) >> 16; }
__device__ __forceinline__ unsigned pk2(float lo, float hi) { return f2bf(lo) | (f2bf(hi) << 16); }
#define XB_TMO      128
#define XB_XCNT(j)  (256  + 64 * (j))
#define XB_XSUB(j)  (1280 + 64 * (j))
#define XB_XGEN(j)  (2304 + 64 * (j))
#define XB_TOP      3328
#define XB_TOPGEN   3392
#define XCD_BAR_WORDS 3456
#define XB_SPIN_CAP (1u << 18)

__device__ __forceinline__ unsigned xb_ld(unsigned* p)              { return __hip_atomic_load(p, __ATOMIC_RELAXED, __HIP_MEMORY_SCOPE_AGENT); }
__device__ __forceinline__ unsigned xb_add(unsigned* p, unsigned v) { return __hip_atomic_fetch_add(p, v, __ATOMIC_RELAXED, __HIP_MEMORY_SCOPE_AGENT); }
__device__ __forceinline__ unsigned xb_xcc_id() { return (unsigned)__builtin_amdgcn_s_getreg((3 << 11) | 20) & 0xFu; }
#define XB_SPIN(cond, bar) do { unsigned _sp = 0; while (cond) { __builtin_amdgcn_s_sleep(1); \
    if ((++_sp & 255u) == 0u) { if (xb_ld(&(bar)[XB_TMO])) break; if (_sp > XB_SPIN_CAP) { atomicAdd(&(bar)[XB_TMO], 1u); break; } } } } while (0)

struct XcdBarrier {
    unsigned* bar; unsigned x; unsigned w0;
    volatile LAS unsigned* st;
};

__device__ __forceinline__ XcdBarrier xcd_barrier_post(unsigned* bar, volatile LAS unsigned* st, unsigned w0) {
    XcdBarrier b; b.bar = bar; b.x = xb_xcc_id(); b.st = st; b.w0 = w0;
    if (threadIdx.x == 0) (void)xb_add(&bar[XB_XCNT(b.x)], 1u);
    return b;
}
__device__ __forceinline__ void xcd_barrier_complete(unsigned* bar, unsigned x, unsigned& nloc, unsigned& nx) {
    const unsigned G = gridDim.x * gridDim.y * gridDim.z;
    unsigned sum, cnt, mine, sp = 0u;
    for (;;) {
        sum = 0u; cnt = 0u; mine = 0u;
#pragma unroll
        for (unsigned j = 0; j < 16; ++j) { const unsigned c = xb_ld(&bar[XB_XCNT(j)]); sum += c; cnt += (c > 0u) ? 1u : 0u; mine = (j == x) ? c : mine; }
        if (sum == G) break;
        __builtin_amdgcn_s_sleep(1);
        if ((++sp & 255u) == 0u) { if (xb_ld(&bar[XB_TMO])) break; if (sp > XB_SPIN_CAP) { atomicAdd(&bar[XB_TMO], 1u); break; } }
    }
    nloc = mine > 0u ? mine : 1u; nx = cnt > 0u ? cnt : 1u;
}

__device__ __forceinline__ void xcd_barrier(const XcdBarrier& b) {
    asm volatile("s_waitcnt vmcnt(0)" ::: "memory");
    __syncthreads();
    if (b.w0 == 0u && mk_lane() == 0) {
        unsigned* bar = b.bar;
        __builtin_amdgcn_s_waitcnt(0);
        unsigned nloc = b.st[0], nx = b.st[1];
        if (nloc == 0u) { xcd_barrier_complete(bar, b.x, nloc, nx); b.st[0] = nloc; b.st[1] = nx; }
        const unsigned old = xb_add(&bar[XB_XSUB(b.x)], 1u);
        const unsigned gen = old / nloc;
        if (old + 1u == (gen + 1u) * nloc) {
            __builtin_amdgcn_fence(__ATOMIC_RELEASE, "agent");
            asm volatile("s_waitcnt vmcnt(0)" ::: "memory");
            const unsigned og = xb_add(&bar[XB_TOP], 1u);
            const unsigned tg = og / nx;
            if (og + 1u == (tg + 1u) * nx) xb_add(&bar[XB_TOPGEN], 1u);
            else XB_SPIN(xb_ld(&bar[XB_TOPGEN]) == tg, bar);
            __builtin_amdgcn_fence(__ATOMIC_ACQUIRE, "agent");
            xb_add(&bar[XB_XGEN(b.x)], 1u);
            asm volatile("s_waitcnt vmcnt(0)" ::: "memory");
        } else {
            XB_SPIN(xb_ld(&bar[XB_XGEN(b.x)]) == gen, bar);
            __builtin_amdgcn_fence(__ATOMIC_ACQUIRE, "agent");
            asm volatile("s_waitcnt vmcnt(0)" ::: "memory");
        }
    }
    __syncthreads();
}

constexpr int NB = 16, T = 2048, NT = NB * T, D = 1024, FF = 2816, NMEM = 256;
constexpr float EPS = 1e-6f;
constexpr int NWAVES = 8;
constexpr float LOG2E = 1.4426950408889634f;

namespace pg8 {
__device__ __forceinline__ u32x4 pack8(const f32x4 v0, const f32x4 v1) {
    u32x4 w; w.x = cvt_pk_bf16(v0[0], v0[1]); w.y = cvt_pk_bf16(v0[2], v0[3]); w.z = cvt_pk_bf16(v1[0], v1[1]); w.w = cvt_pk_bf16(v1[2], v1[3]); return w;
}
__device__ __forceinline__ float sigmoidf_(float x) { return __builtin_amdgcn_rcpf(1.0f + __builtin_amdgcn_exp2f(-1.4426950408889634f * x)); }
__device__ __forceinline__ f32x2 sigmoid2_(const f32x2 x) { const f32x2 t = x * (-1.4426950408889634f); f32x2 d = {__builtin_amdgcn_exp2f(t[0]), __builtin_amdgcn_exp2f(t[1])}; d = d + 1.0f; return (f32x2){__builtin_amdgcn_rcpf(d[0]), __builtin_amdgcn_rcpf(d[1])}; }
__device__ __forceinline__ float bf_lo(unsigned w) { return __builtin_bit_cast(float, w << 16); }
__device__ __forceinline__ float bf_hi(unsigned w) { return __builtin_bit_cast(float, w & 0xffff0000u); }
__device__ __forceinline__ void st16_wt(void* p, const u32x4 v) {
#if MK_WT_STORE == 1
    asm volatile("global_store_dwordx4 %0, %1, off sc1\n\ts_nop 1" :: "v"(p), "v"(v) : "memory");
#elif MK_WT_STORE == 3
    asm volatile("global_store_dwordx4 %0, %1, off sc1 nt\n\ts_nop 1" :: "v"(p), "v"(v) : "memory");
#elif MK_WT_STORE == 2
    __builtin_nontemporal_store(v, (u32x4*)p);
#else
    *(u32x4*)p = v;
#endif
}

#define EPI_DEFAULTS \
    __device__ __forceinline__ size_t koff(const Unit&) const { return 0; } \
    __device__ __forceinline__ bool keep(const Unit&) const { return false; } \
    __device__ __forceinline__ void mid(f32x4 (&)[2][2][4][2], const Unit&, int, int, int, int, int) const {}
struct EpiSplit {
    EPI_DEFAULTS
    static constexpr bool PERM = true, AFTER_DRAIN = false, HAS_MID = false;
    bf16_t* O0; int ld0; int nt0; bf16_t* O1; int ld1; float s0, s1;
    __device__ __forceinline__ void operator()(const f32x4 (&acc)[2][2][4][2], const Unit& u, int wr, int wc, int fr, int fq) const {
        const bool first = u.pn < nt0;
        bf16_t* base = first ? O0 : O1; const int ld = first ? ld0 : ld1; const float sc = first ? s0 : s1;
        const int colt = (first ? u.pn : u.pn - nt0) * BM;
        const int row0 = u.pm * BM + wr * 64 + fr, col0 = colt + wc * 32 + 8 * fq;
#pragma unroll
        for (int ai = 0; ai < 2; ++ai)
#pragma unroll
            for (int m = 0; m < 4; ++m) { bf16_t* rowp = base + (size_t)(row0 + ai * HALF + m * 16) * ld + col0;
#pragma unroll
                for (int bj = 0; bj < 2; ++bj) *(u32x4*)(rowp + bj * HALF) = pack8(acc[ai][bj][m][0] * sc, acc[ai][bj][m][1] * sc); }
    }
};
struct EpiSwiglu {
    EPI_DEFAULTS
    static constexpr bool PERM = true, AFTER_DRAIN = false, HAS_MID = false;
    bf16_t* O; int ldc;
    __device__ __forceinline__ void operator()(const f32x4 (&acc)[2][2][4][2], const Unit& u, int wr, int wc, int fr, int fq) const {
        const int row0 = u.pm * BM + wr * 64 + fr, col0 = u.pn * HALF + wc * 32 + 8 * fq;
#pragma unroll
        for (int ai = 0; ai < 2; ++ai)
#pragma unroll
            for (int m = 0; m < 4; ++m) {
                f32x4 h[2];
#pragma unroll
                for (int n = 0; n < 2; ++n)
#pragma unroll
                    for (int j = 0; j < 4; j += 2) {
                        const f32x2 g2 = {acc[ai][0][m][n][j], acc[ai][0][m][n][j + 1]}, u2 = {acc[ai][1][m][n][j], acc[ai][1][m][n][j + 1]};
                        const f32x2 t2 = g2 * (-1.4426950408889634f);
                        f32x2 d2 = {__builtin_amdgcn_exp2f(t2[0]), __builtin_amdgcn_exp2f(t2[1])}; d2 = d2 + 1.0f;
                        const f32x2 r2 = {__builtin_amdgcn_rcpf(d2[0]), __builtin_amdgcn_rcpf(d2[1])};
                        const f32x2 o2 = (g2 * r2) * u2; h[n][j] = o2[0]; h[n][j + 1] = o2[1]; }
                st16_wt(O + (size_t)(row0 + ai * HALF + m * 16) * ldc + col0, pack8(h[0], h[1]));
            }
    }
};
struct EpiGates {
    EPI_DEFAULTS
    static constexpr bool PERM = true, AFTER_DRAIN = false, HAS_MID = false;
    bf16_t* O; int ldc;
    __device__ __forceinline__ void operator()(const f32x4 (&acc)[2][2][4][2], const Unit& u, int wr, int wc, int fr, int fq) const {
        const int row0 = u.pm * BM + wr * 64 + fr, col0 = u.pn * BM + wc * 32 + 8 * fq;
#pragma unroll
        for (int ai = 0; ai < 2; ++ai)
#pragma unroll
            for (int m = 0; m < 4; ++m) { bf16_t* rowp = O + (size_t)(row0 + ai * HALF + m * 16) * ldc + col0;
#pragma unroll
                for (int bj = 0; bj < 2; ++bj) { f32x4 a, b;
#pragma unroll
                    for (int j = 0; j < 4; j += 2) {
                        const f32x2 sa = sigmoid2_((f32x2){acc[ai][bj][m][0][j], acc[ai][bj][m][0][j + 1]}), sb = sigmoid2_((f32x2){acc[ai][bj][m][1][j], acc[ai][bj][m][1][j + 1]});
                        a[j] = fmaxf(sa[0], 1e-6f); a[j + 1] = fmaxf(sa[1], 1e-6f); b[j] = fmaxf(sb[0], 1e-6f); b[j + 1] = fmaxf(sb[1], 1e-6f); }
                    st16_wt(rowp + bj * HALF, pack8(a, b)); } }
    }
};
struct EpiWinA {
    EPI_DEFAULTS
    static constexpr bool PERM = true, AFTER_DRAIN = false, HAS_MID = false;
    bf16_t* CQ; bf16_t* CKV; float* KW; bf16_t* U; bf16_t* QM; const float* kvg; float qm_scale; PG8_LAS float* red;
    __device__ __forceinline__ void operator()(const f32x4 (&acc)[2][2][4][2], const Unit& u, int wr, int wc, int fr, int fq) const {
        const int row0 = u.pm * BM + wr * 64 + fr; const int cw = wc * 32 + 8 * fq;
        const int pn = u.pn;
        if (pn <= 1) {
#pragma unroll
            for (int ai = 0; ai < 2; ++ai)
#pragma unroll
                for (int m = 0; m < 4; ++m) { float s = 0.f;
#pragma unroll
                    for (int bj = 0; bj < 2; ++bj)
#pragma unroll
                        for (int n = 0; n < 2; ++n) { const f32x4 x = acc[ai][bj][m][n]; s += (x[0] * x[0] + x[1] * x[1]) + (x[2] * x[2] + x[3] * x[3]); }
                    s += __shfl_xor(s, 16); s += __shfl_xor(s, 32);
                    if (fq == 0) red[(ai * HALF + wr * 64 + m * 16 + fr) * 4 + wc] = s; }
            asm volatile("s_waitcnt lgkmcnt(0)" ::: "memory"); __builtin_amdgcn_s_barrier(); asm volatile("" ::: "memory");
            bf16_t* O = pn == 0 ? CQ : CKV;
            f32x4 gv[2][2];
#pragma unroll
            for (int bj = 0; bj < 2; ++bj)
#pragma unroll
                for (int n = 0; n < 2; ++n) gv[bj][n] = pn == 0 ? (f32x4){1.f, 1.f, 1.f, 1.f} : *(const f32x4*)(kvg + bj * HALF + cw + 4 * n);
#pragma unroll
            for (int ai = 0; ai < 2; ++ai)
#pragma unroll
                for (int m = 0; m < 4; ++m) { const int r = ai * HALF + wr * 64 + m * 16 + fr;
                    const f32x4 p = *(const PG8_LAS f32x4*)(red + r * 4);
                    const float rstd = __builtin_amdgcn_rsqf(((p[0] + p[1]) + (p[2] + p[3])) * (1.0f / 256.0f) + 1e-6f);
                    bf16_t* rowp = O + (size_t)(row0 + ai * HALF + m * 16) * 256 + cw;
#pragma unroll
                    for (int bj = 0; bj < 2; ++bj) *(u32x4*)(rowp + bj * HALF) = pack8(acc[ai][bj][m][0] * rstd * gv[bj][0], acc[ai][bj][m][1] * rstd * gv[bj][1]); }
        } else if (pn == 2) {
#pragma unroll
            for (int ai = 0; ai < 2; ++ai)
#pragma unroll
                for (int m = 0; m < 4; ++m) { float* rowp = KW + (size_t)(row0 + ai * HALF + m * 16) * 128 + cw;
                    *(f32x4*)(rowp) = acc[ai][0][m][0]; *(f32x4*)(rowp + 4) = acc[ai][0][m][1]; }
        } else if (pn <= 6) {
            const int col0 = (pn - 3) * HALF + cw;
#pragma unroll
            for (int ai = 0; ai < 2; ++ai)
#pragma unroll
                for (int m = 0; m < 4; ++m) { f32x4 h[2];
#pragma unroll
                    for (int n = 0; n < 2; ++n)
#pragma unroll
                        for (int j = 0; j < 4; j += 2) { const f32x2 sg = sigmoid2_((f32x2){acc[ai][1][m][n][j], acc[ai][1][m][n][j + 1]}); h[n][j] = acc[ai][0][m][n][j] * sg[0]; h[n][j + 1] = acc[ai][0][m][n][j + 1] * sg[1]; }
                    *(u32x4*)(U + (size_t)(row0 + ai * HALF + m * 16) * 512 + col0) = pack8(h[0], h[1]); }
        } else {
            const int col0 = (pn - 7) * BM + cw;
#pragma unroll
            for (int ai = 0; ai < 2; ++ai)
#pragma unroll
                for (int m = 0; m < 4; ++m) { bf16_t* rowp = QM + (size_t)(row0 + ai * HALF + m * 16) * 512 + col0;
#pragma unroll
                    for (int bj = 0; bj < 2; ++bj) *(u32x4*)(rowp + bj * HALF) = pack8(acc[ai][bj][m][0] * qm_scale, acc[ai][bj][m][1] * qm_scale); }
        }
    }
};
struct EpiMerge {
    static constexpr bool PERM = true, AFTER_DRAIN = false, HAS_MID = false;
    const bf16_t* G; bf16_t* O;
    __device__ __forceinline__ size_t koff(const Unit& u) const { return (size_t)u.seg * 1024; }
    __device__ __forceinline__ bool keep(const Unit& u) const { return u.seg < 2; }
    __device__ __forceinline__ void mid(f32x4 (&)[2][2][4][2], const Unit&, int, int, int, int, int) const {}
    __device__ __forceinline__ void operator()(f32x4 (&acc)[2][2][4][2], const Unit& u, int wr, int wc, int fr, int fq) const {
        const int row0 = u.pm * BM + wr * 64 + fr, col0 = u.pn * BM + wc * 32 + 8 * fq;
        const int from = u.seg; const bool last = u.seg == 2;
#pragma unroll
        for (int ai = 0; ai < 2; ++ai)
#pragma unroll
            for (int m = 0; m < 4; ++m) { const bf16_t* rowp = G + (size_t)(row0 + ai * HALF + m * 16) * 3072 + col0; bf16_t* orow = O + (size_t)(row0 + ai * HALF + m * 16) * 1024 + col0;
#pragma unroll
                for (int bj = 0; bj < 2; ++bj) {
                    const u32x4 gf = *(const u32x4*)(rowp + from * 1024 + bj * HALF);
                    u32x4 gt = (u32x4){0x3f803f80u, 0x3f803f80u, 0x3f803f80u, 0x3f803f80u};
                    if (!last) gt = *(const u32x4*)(rowp + (from + 1) * 1024 + bj * HALF);
#pragma unroll
                    for (int q = 0; q < 4; ++q) {
                        float r0 = bf_lo(gf[q]), r1 = bf_hi(gf[q]); if (!last) { r0 *= __builtin_amdgcn_rcpf(bf_lo(gt[q])); r1 *= __builtin_amdgcn_rcpf(bf_hi(gt[q])); }
                        acc[ai][bj][m][q >> 1][(q & 1) * 2] *= r0; acc[ai][bj][m][q >> 1][(q & 1) * 2 + 1] *= r1; }
                    if (last) *(u32x4*)(orow + bj * HALF) = pack8(acc[ai][bj][m][0], acc[ai][bj][m][1]); }
                asm volatile("" : "+v"(acc[ai][0][m][0]), "+v"(acc[ai][0][m][1]), "+v"(acc[ai][1][m][0]), "+v"(acc[ai][1][m][1]));
                if (m == 3) asm volatile("" ::: "memory"); }
    }
};
struct MergeOrder {
    StaticOrder base;
    __device__ bool next(int i, Unit& u) const { if (!base.next(i / 3, u)) return false; u.seg = i % 3; return true; }
    __device__ __forceinline__ void a_ready(const Unit&) const {}
    __device__ __forceinline__ void done(const Unit&) const {}
};
}

constexpr size_t MiB = 1u << 20;
constexpr size_t WS_CTL = 0, CTL_ZERO_BYTES = 1 * MiB;
constexpr size_t WS_WGU1 = 1 * MiB;
constexpr size_t WS_WDN1 = 12 * MiB;
constexpr size_t WS_WIN = 18 * MiB;
constexpr size_t WS_WQ = 29 * MiB;
constexpr size_t WS_WKV = WS_WQ + 512 * 1024;
constexpr size_t WS_WCAT = 30 * MiB;
constexpr size_t WS_WOUT = 33 * MiB;
constexpr size_t WS_WMK = 35 * MiB, WS_WMV = 36 * MiB;
constexpr size_t WS_WGU2 = 37 * MiB, WS_WDN2 = 48 * MiB;
constexpr size_t WS_H = 54 * MiB;
constexpr size_t WS_Y = 118 * MiB;
constexpr size_t WS_BIG = 182 * MiB;
constexpr size_t WS_CQ = WS_BIG, WS_CKV = WS_BIG + 16 * MiB, WS_KW = WS_BIG + 32 * MiB, WS_Q = WS_BIG + 48 * MiB, WS_KP = WS_BIG + 80 * MiB, WS_VP = WS_BIG + 112 * MiB,
                 WS_QIDX = WS_BIG + 144 * MiB, WS_KIDX = WS_BIG + 160 * MiB, WS_WIDX = WS_BIG + 164 * MiB, WS_MASKT = WS_BIG + 168 * MiB;
constexpr size_t WS_ACT = 374 * MiB;
constexpr size_t WS_MEMN = 470 * MiB, WS_MK = 478 * MiB, WS_MVT = 482 * MiB, WS_RS = 486 * MiB, WS_END = 487 * MiB;
static_assert(WS_WGU1 + (size_t)5632 * 1024 * 2 <= WS_WDN1 && WS_WDN1 + (size_t)1024 * 2816 * 2 <= WS_WIN && WS_WIN + (size_t)5376 * 1024 * 2 <= WS_WQ && WS_WKV + (size_t)1024 * 256 * 2 <= WS_WCAT &&
              WS_WCAT + (size_t)1024 * 1536 * 2 <= WS_WOUT && WS_WOUT + 2 * MiB <= WS_WMK && WS_WGU2 + 11 * MiB <= WS_WDN2 && WS_WDN2 + (size_t)1024 * 2816 * 2 <= WS_H, "weights map");
static_assert(WS_BIG + (size_t)NT * 2816 * 2 <= WS_ACT && WS_BIG + (size_t)NT * 3072 * 2 <= WS_ACT && WS_ACT + (size_t)NT * 1536 * 2 <= WS_MEMN && WS_WIDX + (size_t)NT * 16 <= WS_ACT, "act map");
constexpr int CW_BAR = 4096;

constexpr int RING_BYTES = 131072;
constexpr int LDSCTL_OFF = RING_BYTES, MISC_OFF = LDSCTL_OFF + 320, RED_OFF = RING_BYTES + 1024, PTAB_OFF = RING_BYTES + 8192;
constexpr int LDS_BYTES = 147456;

struct Frame {
    LAS unsigned char* lds;
    int tid, lane, wave, G, wave0;
    const float* in[31]; float* out; unsigned char* ws;
};

__device__ __forceinline__ float wave_sum(float v) {
#pragma unroll
    for (int o = 1; o < 64; o <<= 1) v += __shfl_xor(v, o);
    return v;
}
__device__ __forceinline__ float wave_max(float v) {
#pragma unroll
    for (int o = 1; o < 64; o <<= 1) v = fmaxf(v, __shfl_xor(v, o));
    return v;
}
__device__ __forceinline__ float wave_sum_dpp_f(float v) {
#define DPPF_(ctrl, rm) v += __builtin_bit_cast(float, __builtin_amdgcn_update_dpp(0, __builtin_bit_cast(int, v), ctrl, rm, 0xf, false))
    DPPF_(0xb1, 0xf); DPPF_(0x4e, 0xf); DPPF_(0x124, 0xf); DPPF_(0x128, 0xf); DPPF_(0x142, 0xa); DPPF_(0x143, 0xc);
#undef DPPF_
    return v;
}
__device__ __forceinline__ float bf2f(unsigned short b) { return __builtin_bit_cast(float, (unsigned)b << 16); }

__device__ __forceinline__ int map_col(int kind, int off, int np) {
    if (kind == 0) return off + np;
    const int tile = np >> 8, i = np & 255;
    if (kind == 1) return i < 128 ? tile * 128 + i : 2816 + tile * 128 + (i - 128);
    if (tile <= 1) return np;
    if (tile == 2) return i < 68 ? 512 + i : -1;
    if (tile <= 6) { const int j = tile - 3; return i < 128 ? 580 + j * 128 + i : 1092 + j * 128 + (i - 128); }
    return 1604 + (tile - 7) * 256 + i;
}
__device__ __forceinline__ void transpose_item(const float* W, int srcN, bf16* WT, int ldo, int koff, int nblk, int kind, int off, const float* rowscale, float scale, LAS float* scr, int item, int lane) {
    const int kb = item / nblk, nb = item % nblk, k0 = 64 * kb, n0 = 32 * nb;
    const int col = map_col(kind, off, n0 + (lane & 31));
    float wv_[32];
#pragma unroll
    for (int i = 0; i < 32; ++i) { const int kk = 2 * i + (lane >> 5); wv_[i] = col >= 0 ? __builtin_nontemporal_load(W + (size_t)(k0 + kk) * srcN + col) : 0.f; }
    float rs_[32];
#pragma unroll
    for (int i = 0; i < 32; ++i) rs_[i] = rowscale ? rowscale[k0 + 2 * i + (lane >> 5)] : 1.f;
#pragma unroll
    for (int i = 0; i < 32; ++i) { const int kk = 2 * i + (lane >> 5);
        scr[kk * 33 + (lane & 31)] = wv_[i] * scale * rs_[i]; }
    LDS_WAIT(); asm volatile("" ::: "memory");
    const int c = lane & 7;
#pragma unroll
    for (int j = 0; j < 4; ++j) { const int n = (lane >> 3) + 8 * j; const LAS float* s = scr + (8 * c) * 33 + n;
        v4u o; o.x = pk2(s[0 * 33], s[1 * 33]); o.y = pk2(s[2 * 33], s[3 * 33]); o.z = pk2(s[4 * 33], s[5 * 33]); o.w = pk2(s[6 * 33], s[7 * 33]);
        *(v4u*)(WT + (size_t)(n0 + n) * ldo + koff + k0 + 8 * c) = o; }
    LDS_WAIT(); asm volatile("" ::: "memory");
}
__device__ __forceinline__ void rms_row_to_bf16(const float* xrow, bf16* orow, int lane) {
    const f32x4* xr = (const f32x4*)xrow + lane;
    f32x4 v[4]; float s = 0.f;
#pragma unroll
    for (int j = 0; j < 4; ++j) { v[j] = xr[64 * j]; s += (v[j].x * v[j].x + v[j].y * v[j].y) + (v[j].z * v[j].z + v[j].w * v[j].w); }
    const float rstd = 1.0f / sqrtf(wave_sum(s) * (1.f / 1024.f) + EPS);
    unsigned long long* o8 = (unsigned long long*)orow + lane;
#pragma unroll
    for (int j = 0; j < 4; ++j) o8[64 * j] = (unsigned long long)pk2(v[j].x * rstd, v[j].y * rstd) | ((unsigned long long)pk2(v[j].z * rstd, v[j].w * rstd) << 32);
}
struct TrJob { int src; int srcN; size_t dst; int ldo, koff, K, nout, kind, off, rs; float scale; };
__constant__ TrJob JOBS[16] = {
        {4, 5632, WS_WGU1, 1024, 0, 1024, 5632, 1, 0, 2, 1.f},
        {5, 1024, WS_WDN1, 2816, 0, 2816, 1024, 0, 0, -1, 1.f},
        {8, 5188, WS_WIN, 1024, 0, 1024, 2304, 2, 0, 6, 1.f},
        {8, 5188, WS_WIN + (size_t)2304 * 1024 * 2, 1024, 0, 1024, 3072, 0, 2116, 6, 1.f},
        {11, 512, WS_WQ, 256, 0, 256, 512, 0, 0, 9, 0.125f * LOG2E},
        {14, 256, WS_WQ + (size_t)512 * 256 * 2, 256, 0, 256, 256, 0, 0, 9, 0.125f},
        {12, 512, WS_WKV, 256, 0, 256, 512, 0, 0, -1, 1.f},
        {13, 512, WS_WKV + (size_t)512 * 256 * 2, 256, 0, 256, 512, 0, 0, -1, 1.f},
        {17, 1024, WS_WCAT, 1536, 0, 512, 1024, 0, 0, -1, 1.f},
        {22, 1024, WS_WCAT, 1536, 512, 512, 1024, 0, 0, -1, 1.f},
        {25, 1024, WS_WCAT, 1536, 1024, 512, 1024, 0, 0, -1, 1.f},
        {26, 1024, WS_WOUT, 1024, 0, 1024, 1024, 0, 0, -1, 1.f},
        {24, 1024, WS_WMK, 1024, 0, 1024, 512, 0, 0, 23, 1.f},
        {24, 1024, WS_WMV, 1024, 0, 1024, 512, 0, 512, 23, 1.f},
        {29, 5632, WS_WGU2, 1024, 0, 1024, 5632, 1, 0, 27, 1.f},
        {30, 1024, WS_WDN2, 2816, 0, 2816, 1024, 0, 0, -1, 1.f},
    };
__device__ __forceinline__ void repack_jobs(Frame& F, const int j_lo, const int j_hi) {
    { int t_ = F.wave0 * 64 + mk_lane(); asm volatile("" : "+v"(t_)); F.tid = t_; F.lane = t_ & 63; F.wave = __builtin_amdgcn_readfirstlane(t_ >> 6); }
    LAS float* scr = (LAS float*)(F.lds + F.wave * 16384);
    const int gw = blockIdx.x * NWAVES + F.wave, NGW = F.G * NWAVES;
    LAS unsigned long long* ptab = (LAS unsigned long long*)(F.lds + PTAB_OFF);
    if (F.tid == 0) {
#pragma unroll
        for (int i = 0; i < 31; ++i) ptab[i] = (unsigned long long)(uintptr_t)F.in[i]; }
    __syncthreads();
    int base = 0;
#pragma unroll 1
    for (int j = j_lo; j < j_hi; ++j) {
        const TrJob jb = JOBS[j];
        const int nblk = jb.nout / 32, nitems = (jb.K / 64) * nblk;
        int first = (gw - (base % NGW) + NGW) % NGW;
        for (int it = first; it < nitems; it += NGW)
            transpose_item((const float*)(uintptr_t)ptab[jb.src], jb.srcN, (bf16*)(F.ws + jb.dst), jb.ldo, jb.koff, nblk, jb.kind, jb.off, jb.rs >= 0 ? (const float*)(uintptr_t)ptab[jb.rs] : nullptr, jb.scale, scr, it, F.lane);
        base += nitems;
    }
    __syncthreads();
}
__device__ __forceinline__ void p0_prologue(Frame& F) {
    repack_jobs(F, 0, 1);
    const int gw = blockIdx.x * NWAVES + F.wave, NGW = F.G * NWAVES;
    bf16* H = (bf16*)(F.ws + WS_H); bf16* MEMN = (bf16*)(F.ws + WS_MEMN);
    { f32x4 v[4], vn[4];
      if (gw < NT) {
#pragma unroll
          for (int j = 0; j < 4; ++j) v[j] = __builtin_nontemporal_load((const f32x4*)(F.in[0] + (size_t)gw * D) + F.lane + 64 * j); }
      for (int m = gw; m < NT; m += NGW) { const int mn = m + NGW;
          if (mn < NT) {
#pragma unroll
              for (int j = 0; j < 4; ++j) vn[j] = __builtin_nontemporal_load((const f32x4*)(F.in[0] + (size_t)mn * D) + F.lane + 64 * j); }
          float s = 0.f;
#pragma unroll
          for (int j = 0; j < 4; ++j) s += (v[j].x * v[j].x + v[j].y * v[j].y) + (v[j].z * v[j].z + v[j].w * v[j].w);
          const float sq0 = sqrtf(__shfl(wave_sum_dpp_f(s), 63) * (1.f / 1024.f) + EPS), rstd = 1.0f / sq0;
          if (F.lane == 0) ((float*)(F.ws + WS_RS))[2 * NT + m] = sq0;
          unsigned long long* o8 = (unsigned long long*)(H + (size_t)m * D) + F.lane;
#pragma unroll
          for (int j = 0; j < 4; ++j) o8[64 * j] = (unsigned long long)pk2(v[j].x * rstd, v[j].y * rstd) | ((unsigned long long)pk2(v[j].z * rstd, v[j].w * rstd) << 32);
#pragma unroll
          for (int j = 0; j < 4; ++j) v[j] = vn[j]; } }
    for (int m = gw; m < NB * NMEM; m += NGW) rms_row_to_bf16(F.in[1] + (size_t)m * D, MEMN + (size_t)m * D, F.lane);
}

template <int XM, int OM>
__device__ __forceinline__ void ew_phase(Frame& F, const bf16* Y, const void* xin_, const float* xs, const float* gain, float coef, void* xout_, bf16* hout, float* rs) {
    { int t_ = F.wave0 * 64 + mk_lane(); asm volatile("" : "+v"(t_)); F.tid = t_; F.lane = t_ & 63; F.wave = __builtin_amdgcn_readfirstlane(t_ >> 6); }
    const int gw = blockIdx.x * NWAVES + F.wave, NGW = F.G * NWAVES, lane = F.lane;
    constexpr bool XI16 = XM != 0;
    f32x4 gv[4];
#pragma unroll
    for (int j = 0; j < 4; ++j) gv[j] = ((const f32x4*)gain)[lane + 64 * j] * coef;
    unsigned long long yw[4], ywn[4], ywn2[4], xw[4], xwn[4], xwn2[4]; f32x4 xv[4], xvn[4], xvn2[4]; float sx = 1.f, sxn = 1.f, sxn2 = 1.f;
#define EW_LOAD(m_, yw_, xv_, xw_, sx_) do { _Pragma("unroll") for (int j = 0; j < 4; ++j) { yw_[j] = __builtin_nontemporal_load((const unsigned long long*)(Y + (size_t)(m_) * D) + lane + 64 * j);     \
        if (XI16) xw_[j] = __builtin_nontemporal_load((const unsigned long long*)((const bf16*)xin_ + (size_t)(m_) * D) + lane + 64 * j); else xv_[j] = __builtin_nontemporal_load((const f32x4*)((const float*)xin_ + (size_t)(m_) * D) + lane + 64 * j); } \
        if (XM == 2) sx_ = xs[m_]; } while (0)
#define EW_UNPK(w_, v_) do { v_.x = bf2f((unsigned short)(w_)); v_.y = bf2f((unsigned short)((w_) >> 16)); v_.z = bf2f((unsigned short)((w_) >> 32)); v_.w = bf2f((unsigned short)((w_) >> 48)); } while (0)
    if (gw < NT) EW_LOAD(gw, yw, xv, xw, sx);
    if (gw + NGW < NT) EW_LOAD(gw + NGW, ywn, xvn, xwn, sxn);
    for (int m = gw; m < NT; m += NGW) {
        const int mn = m + 2 * NGW;
        if (mn < NT) EW_LOAD(mn, ywn2, xvn2, xwn2, sxn2);
        f32x4 yv[4]; float s = 0.f;
#pragma unroll
        for (int j = 0; j < 4; ++j) { EW_UNPK(yw[j], yv[j]); if (XI16) EW_UNPK(xw[j], xv[j]); if (XM == 2) xv[j] = xv[j] * sx;
            s += (yv[j].x * yv[j].x + yv[j].y * yv[j].y) + (yv[j].z * yv[j].z + yv[j].w * yv[j].w); }
        const float rstd = 1.0f / sqrtf(__shfl(wave_sum_dpp_f(s), 63) * (1.f / 1024.f) + EPS);
        float s2 = 0.f;
#pragma unroll
        for (int j = 0; j < 4; ++j) { xv[j] = xv[j] + gv[j] * yv[j] * rstd; s2 += (xv[j].x * xv[j].x + xv[j].y * xv[j].y) + (xv[j].z * xv[j].z + xv[j].w * xv[j].w); }
        if (OM == 1) { unsigned long long* xo = (unsigned long long*)((bf16*)xout_ + (size_t)m * D) + lane;
#pragma unroll
            for (int j = 0; j < 4; ++j) __builtin_nontemporal_store((unsigned long long)pk2(xv[j].x, xv[j].y) | ((unsigned long long)pk2(xv[j].z, xv[j].w) << 32), xo + 64 * j);
        } else if (OM == 0) { f32x4* xo = (f32x4*)((float*)xout_ + (size_t)m * D) + lane;
#pragma unroll
            for (int j = 0; j < 4; ++j) __builtin_nontemporal_store(xv[j], xo + 64 * j); }
        if (hout) {
            const float sq = sqrtf(__shfl(wave_sum_dpp_f(s2), 63) * (1.f / 1024.f) + EPS), r2 = 1.0f / sq;
            unsigned long long* o8 = (unsigned long long*)(hout + (size_t)m * D) + lane;
#pragma unroll
            for (int j = 0; j < 4; ++j) o8[64 * j] = (unsigned long long)pk2(xv[j].x * r2, xv[j].y * r2) | ((unsigned long long)pk2(xv[j].z * r2, xv[j].w * r2) << 32);
            if (OM == 2 && lane == 0) rs[m] = sq;
        }
#pragma unroll
        for (int j = 0; j < 4; ++j) { yw[j] = ywn[j]; xv[j] = xvn[j]; xw[j] = xwn[j]; ywn[j] = ywn2[j]; xvn[j] = xvn2[j]; xwn[j] = xwn2[j]; }
        sx = sxn; sxn = sxn2;
    }
#undef EW_LOAD
#undef EW_UNPK
}

__device__ __forceinline__ void kidx_phase(Frame& F) {
    { int t_ = F.wave0 * 64 + mk_lane(); asm volatile("" : "+v"(t_)); F.tid = t_; F.lane = t_ & 63; F.wave = __builtin_amdgcn_readfirstlane(t_ >> 6); }
    const int gw = blockIdx.x * NWAVES + F.wave, NGW = F.G * NWAVES, lane = F.lane;
    const float* KW = (const float*)(F.ws + WS_KW); bf16* KIDX = (bf16*)(F.ws + WS_KIDX); float* WIDX = (float*)(F.ws + WS_WIDX);
    const float g = F.in[15][lane], b = F.in[16][lane];
    for (int m0 = gw; m0 < NT; m0 += 16 * NGW) {
        float vv[16], ww[16];
#pragma unroll
        for (int k = 0; k < 16; ++k) { const int m = m0 + k * NGW; vv[k] = m < NT ? KW[(size_t)m * 128 + lane] : 0.f; ww[k] = (m < NT && lane < 4) ? KW[(size_t)m * 128 + 64 + lane] : 0.f; }
#pragma unroll
        for (int k = 0; k < 16; ++k) { const int m = m0 + k * NGW; if (m < NT) {
            const float v = vv[k];
            const float mean = wave_sum(v) * (1.f / 64.f); const float xc = v - mean;
            const float var = wave_sum(xc * xc) * (1.f / 64.f);
            KIDX[((size_t)(m >> 5) * 8 + (lane >> 3)) * 256 + (m & 31) * 8 + (lane & 7)] = (bf16)f2bf(xc * (1.0f / sqrtf(var + EPS)) * g + b);
            if (lane < 4) WIDX[(size_t)m * 4 + lane] = ww[k] * 0.5f; } }
    }
}

__device__ __forceinline__ void conv_phase(Frame& F) {
    { int t_ = F.wave0 * 64 + mk_lane(); asm volatile("" : "+v"(t_)); F.tid = t_; F.lane = t_ & 63; F.wave = __builtin_amdgcn_readfirstlane(t_ >> 6); }
    const int ch = F.tid, lane = F.lane, wave = F.wave;
    const bf16* U = (const bf16*)(F.ws + WS_Y); bf16* ACT = (bf16*)(F.ws + WS_ACT);
    float wv[31];
#pragma unroll
    for (int j = 0; j < 31; ++j) wv[j] = F.in[18][j * 512 + ch];
    pg8::f32x2 we2[15], wo2[15];
#pragma unroll
    for (int p2 = 0; p2 < 15; ++p2) { we2[p2] = (pg8::f32x2){wv[2 * p2], wv[2 * p2 + 1]}; wo2[p2] = (pg8::f32x2){wv[2 * p2 + 1], wv[2 * p2 + 2]}; }
    const float w0 = wv[0], w30 = wv[30];
    const float bias = F.in[19][ch], lg = F.in[20][ch], lb = F.in[21][ch];
    LAS float* red = (LAS float*)F.lds;
    LAS float* stat = (LAS float*)(F.lds + 4096);
    int par = 0;
    for (int unit = blockIdx.x; unit < NT / 128; unit += F.G) {
        const int tok0 = unit * 128, tb = tok0 % T;
        pg8::f32x2 x2[23];
        float xn[16];
#pragma unroll
        for (int k = 0; k < 30; ++k) { const int pp = tb - 30 + k; const float v = pp >= 0 ? bf2f(U[(size_t)(tok0 - 30 + k) * 512 + ch]) : 0.f; x2[8 + (k >> 1)][k & 1] = v; }
#pragma unroll
        for (int i = 0; i < 16; ++i) xn[i] = bf2f(U[(size_t)(tok0 + i) * 512 + ch]);
#pragma unroll 1
        for (int grp = 0; grp < 8; ++grp) {
#pragma unroll
            for (int k = 0; k < 15; ++k) x2[k] = x2[k + 8];
#pragma unroll
            for (int i = 0; i < 8; ++i) x2[15 + i] = (pg8::f32x2){xn[2 * i], xn[2 * i + 1]};
            if (grp < 7) {
#pragma unroll
                for (int i = 0; i < 16; ++i) xn[i] = bf2f(U[(size_t)(tok0 + (grp + 1) * 16 + i) * 512 + ch]); }
            float y[16];
#pragma unroll
            for (int a2 = 0; a2 < 8; ++a2) {
                pg8::f32x2 e = {bias, 0.f}, o = {bias, 0.f};
#pragma unroll
                for (int p2 = 0; p2 < 15; ++p2) { e = __builtin_elementwise_fma(we2[p2], x2[a2 + p2], e); o = __builtin_elementwise_fma(wo2[p2], x2[a2 + 1 + p2], o); }
                y[2 * a2] = (e[0] + e[1]) + w30 * x2[a2 + 15][0];
                y[2 * a2 + 1] = (o[0] + o[1]) + w0 * x2[a2][1]; }
            { LAS float* Tw = (LAS float*)(F.lds + 8192) + wave * (16 * 68);
#pragma unroll
              for (int i = 0; i < 16; ++i) Tw[i * 68 + lane] = y[i];
              asm volatile("s_waitcnt lgkmcnt(0)" ::: "memory");
              const int tt = lane & 15, q4 = lane >> 4; float s1 = 0.f, s2 = 0.f;
#pragma unroll
              for (int k = 0; k < 4; ++k) { const f32x4 v = *(const LAS f32x4*)(Tw + tt * 68 + 16 * q4 + 4 * k);
                  s1 += (v.x + v.y) + (v.z + v.w); s2 += (v.x * v.x + v.y * v.y) + (v.z * v.z + v.w * v.w); }
              s1 += __shfl_xor(s1, 16); s2 += __shfl_xor(s2, 16); s1 += __shfl_xor(s1, 32); s2 += __shfl_xor(s2, 32);
              if (lane < 16) { red[((par * 16 + tt) * 8 + wave) * 2] = s1; red[((par * 16 + tt) * 8 + wave) * 2 + 1] = s2; } }
            __syncthreads();
            if (F.tid < 16) { float t1 = 0.f, t2 = 0.f;
#pragma unroll
                for (int w = 0; w < 8; ++w) { t1 += red[((par * 16 + F.tid) * 8 + w) * 2]; t2 += red[((par * 16 + F.tid) * 8 + w) * 2 + 1]; }
                const float mean = t1 * (1.f / 512.f), var = fmaxf(t2 * (1.f / 512.f) - mean * mean, 0.f);
                stat[(par * 16 + F.tid) * 2] = mean; stat[(par * 16 + F.tid) * 2 + 1] = 1.0f / sqrtf(var + EPS); }
            __syncthreads();
#pragma unroll
            for (int i = 0; i < 16; ++i) { const float mean = stat[(par * 16 + i) * 2], rstd = stat[(par * 16 + i) * 2 + 1];
                float v = (y[i] - mean) * rstd * lg + lb;
                v = v * pg8::sigmoidf_(v);
                ACT[(size_t)(tok0 + grp * 16 + i) * 1536 + 512 + ch] = (bf16)f2bf(v); }
            par ^= 1;
        }
    }
    __syncthreads();
}

typedef __bf16 bf16x2_dt __attribute__((ext_vector_type(2)));
__device__ __forceinline__ float dot2_ones(unsigned pair, float acc) { return __builtin_amdgcn_fdot2_f32_bf16(__builtin_bit_cast(bf16x2_dt, pair), __builtin_bit_cast(bf16x2_dt, 0x3f803f80u), acc, false); }
constexpr float ATT_THR = 8.0f;
typedef float f32x16 __attribute__((ext_vector_type(16)));
typedef short s16x4 __attribute__((ext_vector_type(4)));
constexpr int MA_K = 0, MA_V = 65536;
__device__ __forceinline__ void memattn_phase(Frame& F) {
    int tid; { int t_ = F.wave0 * 64 + mk_lane(); asm volatile("" : "+v"(t_)); tid = t_; }
    const int lane = tid & 63, wave = __builtin_amdgcn_readfirstlane(tid >> 6), r32 = lane & 31, hi = lane >> 5;
    const bf16* QM = (const bf16*)(F.ws + WS_Y) + (size_t)NT * 512;
    const bf16* MK = (const bf16*)(F.ws + WS_MK);
    const bf16* MVT = (const bf16*)(F.ws + WS_MVT);
    bf16* ACT = (bf16*)(F.ws + WS_ACT);
    const unsigned sw = (unsigned)(r32 & 15);
    for (int task = blockIdx.x; task < NB * 4 * 4; task += F.G) {
        const int bh = task >> 2, b = bh >> 2, h = bh & 3, qpart = task & 3;
#pragma unroll
        for (int n = 0; n < 8; ++n) { const int idx = tid + 512 * n, row = idx >> 4, c = idx & 15;
            const v4u kv = *(const v4u*)(MK + (size_t)(b * 256 + row) * 512 + h * 128 + 8 * c);
            *(LAS v4u*)(F.lds + MA_K + row * 256 + ((c ^ (row & 15)) << 4)) = kv; }
#pragma unroll
        for (int n = 0; n < 8; ++n) { const int idx = tid + 512 * n, row = idx >> 5, gc = idx & 31, sg = gc >> 1, a = gc & 1;
            const v4u vv = *(const v4u*)(MVT + (size_t)(h * 128 + row) * (NB * 256) + b * 256 + 8 * gc);
            *(LAS unsigned long long*)(F.lds + MA_V + row * 512 + (((2 * sg) ^ (row & 15)) << 4) + 8 * a) = (unsigned long long)vv.x | ((unsigned long long)vv.y << 32);
            *(LAS unsigned long long*)(F.lds + MA_V + row * 512 + (((2 * sg + 1) ^ (row & 15)) << 4) + 8 * a) = (unsigned long long)vv.z | ((unsigned long long)vv.w << 32); }
        __syncthreads();
#pragma unroll 1
        for (int grp = 0; grp < 2; ++grp) {
            const size_t tok = (size_t)b * T + qpart * 512 + wave * 64 + grp * 32 + r32;
            bf16x8 qf[8];
#pragma unroll
            for (int ks = 0; ks < 8; ++ks) qf[ks] = *(const bf16x8*)(QM + tok * 512 + h * 128 + 16 * ks + 8 * hi);
            f32x16 o[4]; o[0] = f32x16{}; o[1] = f32x16{}; o[2] = f32x16{}; o[3] = f32x16{};
            float m = -1e30f, l = 0.f;
#pragma unroll 1
            for (int jt = 0; jt < 4; ++jt) {
                f32x16 p0 = {}, p1 = {};
                const LAS unsigned char* kb = F.lds + MA_K + (64 * jt + r32) * 256;
#pragma unroll
                for (int ks = 0; ks < 8; ++ks) { const unsigned ch = (((unsigned)(2 * ks + hi)) ^ sw) << 4;
                    p0 = __builtin_amdgcn_mfma_f32_32x32x16_bf16(*(const LAS bf16x8*)(kb + ch), qf[ks], p0, 0, 0, 0);
                    p1 = __builtin_amdgcn_mfma_f32_32x32x16_bf16(*(const LAS bf16x8*)(kb + 32 * 256 + ch), qf[ks], p1, 0, 0, 0); }
                float mx = fmaxf(p0[0], p1[0]);
#pragma unroll
                for (int r = 1; r < 16; ++r) mx = fmaxf(mx, fmaxf(p0[r], p1[r]));
                mx = fmaxf(mx, __shfl_xor(mx, 32));
                if (jt == 0 || __any(mx > m + ATT_THR)) { const float mn = fmaxf(m, mx), al = __builtin_amdgcn_exp2f(m - mn); m = mn; l *= al;
#pragma unroll
                    for (int db = 0; db < 4; ++db)
#pragma unroll
                        for (int r = 0; r < 16; ++r) o[db][r] *= al; }
#pragma unroll
                for (int r = 0; r < 16; ++r) { p0[r] = __builtin_amdgcn_exp2f(p0[r] - m); p1[r] = __builtin_amdgcn_exp2f(p1[r] - m); }
#pragma unroll
                for (int s = 0; s < 4; ++s) {
                    v4u pw;
                    if (s < 2) { pw.x = pg8::cvt_pk_bf16(p0[8 * s + 0], p0[8 * s + 1]); pw.y = pg8::cvt_pk_bf16(p0[8 * s + 2], p0[8 * s + 3]); pw.z = pg8::cvt_pk_bf16(p0[8 * s + 4], p0[8 * s + 5]); pw.w = pg8::cvt_pk_bf16(p0[8 * s + 6], p0[8 * s + 7]); }
                    else { const int s2 = s - 2; pw.x = pg8::cvt_pk_bf16(p1[8 * s2 + 0], p1[8 * s2 + 1]); pw.y = pg8::cvt_pk_bf16(p1[8 * s2 + 2], p1[8 * s2 + 3]); pw.z = pg8::cvt_pk_bf16(p1[8 * s2 + 4], p1[8 * s2 + 5]); pw.w = pg8::cvt_pk_bf16(p1[8 * s2 + 6], p1[8 * s2 + 7]); }
                    l = dot2_ones(pw.x, l); l = dot2_ones(pw.y, l); l = dot2_ones(pw.z, l); l = dot2_ones(pw.w, l);
                    const bf16x8 pf = __builtin_bit_cast(bf16x8, pw);
                    const unsigned ch = (((unsigned)(8 * jt + 2 * s + hi)) ^ sw) << 4;
#pragma unroll
                    for (int db = 0; db < 4; ++db) o[db] = __builtin_amdgcn_mfma_f32_32x32x16_bf16(*(const LAS bf16x8*)(F.lds + MA_V + (32 * db + r32) * 512 + ch), pf, o[db], 0, 0, 0);
                }
            }
            l += __shfl_xor(l, 32);
            const float rl = 1.0f / l;
            bf16* orow = ACT + tok * 1536 + 1024 + h * 128 + 4 * hi;
#pragma unroll
            for (int db = 0; db < 4; ++db)
#pragma unroll
                for (int g4 = 0; g4 < 4; ++g4)
                    *(unsigned long long*)(orow + 32 * db + 8 * g4) = (unsigned long long)pk2(o[db][4 * g4] * rl, o[db][4 * g4 + 1] * rl) | ((unsigned long long)pk2(o[db][4 * g4 + 2] * rl, o[db][4 * g4 + 3] * rl) << 32);
        }
        __syncthreads();
    }
}

__device__ __forceinline__ int wave_sum_dpp(int v) {
    v += __builtin_amdgcn_update_dpp(0, v, 0xb1, 0xf, 0xf, false);
    v += __builtin_amdgcn_update_dpp(0, v, 0x4e, 0xf, 0xf, false);
    v += __builtin_amdgcn_update_dpp(0, v, 0x124, 0xf, 0xf, false);
    v += __builtin_amdgcn_update_dpp(0, v, 0x128, 0xf, 0xf, false);
    v += __builtin_amdgcn_update_dpp(0, v, 0x142, 0xa, 0xf, false);
    v += __builtin_amdgcn_update_dpp(0, v, 0x143, 0xc, 0xf, false);
    return __builtin_amdgcn_readlane(v, 63);
}
template <int KR> __device__ __forceinline__ void tie_words(const unsigned (&u)[KR], unsigned tau, int ge, int t, int lane, unsigned long long& myword) {
    unsigned wlo = 0u, whi = 0u;
    if (ge == 256) {
#pragma unroll
        for (int k = 0; k < KR; ++k) { const unsigned long long sm = __ballot(u[k] >= tau);
            asm("s_nop 1\n\tv_writelane_b32 %0, %2, %4\n\tv_writelane_b32 %1, %3, %4" : "+v"(wlo), "+v"(whi) : "s"((unsigned)sm), "s"((unsigned)(sm >> 32)), "i"(k)); }
    } else {
        int cgt = 0;
#pragma unroll
        for (int k = 0; k < KR; ++k) cgt += __popcll(__ballot(u[k] > tau));
        const int need = 256 - cgt; int run = 0;
        const unsigned long long lt = (1ull << lane) - 1ull;
#pragma unroll
        for (int k = 0; k < KR; ++k) { const int key = lane + 64 * k; const bool valid = key <= t;
            const bool eq = valid && u[k] == tau; const unsigned long long em = __ballot(eq);
            const bool sel = valid && (u[k] > tau || (eq && run + __popcll(em & lt) < need));
            const unsigned long long sm = __ballot(sel);
            asm("s_nop 1\n\tv_writelane_b32 %0, %2, %4\n\tv_writelane_b32 %1, %3, %4" : "+v"(wlo), "+v"(whi) : "s"((unsigned)sm), "s"((unsigned)(sm >> 32)), "i"(k));
            run += __popcll(em); }
    }
    myword = (unsigned long long)wlo | ((unsigned long long)whi << 32);
}
typedef unsigned short us2_t __attribute__((ext_vector_type(2)));
template <int NP> __device__ __forceinline__ int count_ge16(const unsigned (&pk)[NP], unsigned cand) {
    const unsigned cm1 = cand - 1u; unsigned c2 = cm1 | (cm1 << 16), one = 0x00010001u;
    unsigned a0 = 0u, a1 = 0u, d0, d1;
#pragma unroll
    for (int i = 0; i < NP; i += 2) {
        asm("v_pk_sub_u16 %0, %2, %3 clamp\n\tv_pk_min_u16 %0, %0, %4\n\tv_pk_add_u16 %1, %1, %0" : "=&v"(d0), "+v"(a0) : "v"(pk[i]), "v"(c2), "v"(one));
        asm("v_pk_sub_u16 %0, %2, %3 clamp\n\tv_pk_min_u16 %0, %0, %4\n\tv_pk_add_u16 %1, %1, %0" : "=&v"(d1), "+v"(a1) : "v"(pk[i + 1]), "v"(c2), "v"(one)); }
    unsigned a; asm("v_pk_add_u16 %0, %1, %2" : "=v"(a) : "v"(a0), "v"(a1));
    return wave_sum_dpp((int)((a & 0xffffu) + (a >> 16)));
}
template <int KR> __device__ __forceinline__ unsigned long long select_topk(const LAS float* Sw, int t, int lane) {
    unsigned u[KR];
#pragma unroll
    for (int k = 0; k < KR; ++k) { const int key = lane + 64 * k; const unsigned bits = __builtin_bit_cast(unsigned, Sw[key]);
        const unsigned o = (bits & 0x80000000u) ? ~bits : (bits | 0x80000000u); u[k] = key <= t ? o : 0u; }
    unsigned pk[KR / 2];
#pragma unroll
    for (int i = 0; i < KR / 2; ++i) pk[i] = (u[2 * i] >> 16) | (u[2 * i + 1] & 0xffff0000u);
    unsigned tauh = 0u; int ge = t + 1;
#pragma unroll 1
    for (int bit = 15; bit >= 0 && ge != 256; --bit) { const unsigned cand = tauh | (1u << bit);
        const int cnt = count_ge16<KR / 2>(pk, cand);
        if (cnt >= 256) { tauh = cand; ge = cnt; } }
    unsigned tau = tauh << 16; int gefull = ge;
    if (ge != 256) {
        const int G = tauh == 0xffffu ? 0 : count_ge16<KR / 2>(pk, tauh + 1u);
        const int need2 = 256 - G;
#pragma unroll
        for (int i = 0; i < KR / 2; ++i) { const unsigned lo0 = (u[2 * i] >> 16) == tauh ? (u[2 * i] & 0xffffu) : 0u, lo1 = (u[2 * i + 1] >> 16) == tauh ? (u[2 * i + 1] << 16) : 0u; pk[i] = lo0 | lo1; }
        unsigned taul = 0u; int g2 = ge - G;
#pragma unroll 1
        for (int bit = 15; bit >= 0 && g2 != need2; --bit) { const unsigned cand = taul | (1u << bit);
            const int cnt = count_ge16<KR / 2>(pk, cand);
            if (cnt >= need2) { taul = cand; g2 = cnt; } }
        tau |= taul; gefull = g2 == need2 ? 256 : 257;
    }
    unsigned long long myword = 0ull;
    tie_words<KR>(u, tau, gefull, t, lane, myword);
    return myword;
}

template <int R> __device__ __forceinline__ unsigned bp_rotl(unsigned x, int s) {
    if constexpr (R == 32) return __builtin_amdgcn_alignbit(x, x, (32 - s) & 31); else return ((x << s) | (x >> (R - s))) & ((1u << R) - 1u);
}
template <int R> __device__ __forceinline__ unsigned bp_rotr(unsigned x, int s) {
    if constexpr (R == 32) return __builtin_amdgcn_alignbit(x, x, s); else return ((x >> s) | (x << (R - s))) & ((1u << R) - 1u);
}
template <int R> __device__ __forceinline__ unsigned select_bp(const LAS float* Sq, int t, int lane) {
    constexpr int NC = R / 4, GB = R <= 8 ? 8 : (R <= 16 ? 16 : 32);
    const int rot = R == 32 ? ((lane >> 1) & 7) : (R == 16 ? ((lane >> 2) & 3) : ((lane >> 3) & 1));
    unsigned A[GB];
#pragma unroll
    for (int g = 0; g < NC; ++g) {
        int c = g + rot; if constexpr ((NC & (NC - 1)) != 0) c = c >= NC ? c - NC : c; else c &= NC - 1;
        const pg8::u32x4 v = *(const LAS pg8::u32x4*)(Sq + R * lane + 4 * c);
#pragma unroll
        for (int j = 0; j < 4; ++j) { const unsigned bits = v[j]; A[4 * g + j] = bits ^ ((unsigned)((int)bits >> 31) | 0x80000000u); }
    }
#pragma unroll
    for (int k = R; k < GB; ++k) A[k] = 0u;
#define BP_STAGE(J, M) _Pragma("unroll") for (int k = 0; k < GB; ++k) if ((k & (J)) == 0 && k + (J) < GB) { const unsigned lo = A[k], hi = A[k + (J)]; A[k] = (lo & (M)) | ((hi << (J)) & ~(M)); A[k + (J)] = ((lo >> (J)) & (M)) | (hi & ~(M)); }
    if constexpr (GB > 16) { BP_STAGE(16, 0x0000FFFFu) }
    if constexpr (GB > 8) { BP_STAGE(8, 0x00FF00FFu) }
    BP_STAGE(4, 0x0F0F0F0Fu) BP_STAGE(2, 0x33333333u) BP_STAGE(1, 0x55555555u)
#undef BP_STAGE
    constexpr unsigned MASKR = R == 32 ? ~0u : ((1u << (R & 31)) - 1u);
    const int nv = t + 1 - R * lane;
    const unsigned vmn = nv >= R ? MASKR : (nv <= 0 ? 0u : ((1u << (nv & 31)) - 1u));
    unsigned alive = bp_rotr<R>(vmn, 4 * rot), sel = 0u;
    int need = 256, cnt = t + 1;
#define BP_STEP(b) { unsigned pb; if constexpr (GB == 32) pb = A[(b)]; else pb = (A[(b) & (GB - 1)] >> (GB * ((b) / GB))) & ((1u << (GB & 31)) - 1u); \
        const unsigned ones = alive & pb; const int c = wave_sum_dpp(__popc(ones)); const bool ge = c >= need; \
        alive = ge ? ones : (alive & ~pb); sel = ge ? sel : (sel | ones); cnt = ge ? c : cnt - c; need = ge ? need : need - c; }
#define BP_STEP4(b) BP_STEP(b) BP_STEP((b) - 1) BP_STEP((b) - 2) BP_STEP((b) - 3)
    BP_STEP4(31) BP_STEP4(27) BP_STEP4(23) BP_STEP4(19)
    if (cnt != need) { BP_STEP4(15)
        if (cnt != need) { BP_STEP4(11)
            if (cnt != need) { BP_STEP4(7)
                if (cnt != need) { BP_STEP4(3) } } } }
#undef BP_STEP4
#undef BP_STEP
    if (cnt != need) {
        const unsigned an = bp_rotl<R>(alive, 4 * rot); const int p = __popc(an); int x = p;
#pragma unroll 1
        for (int d = 1; d < 64; d <<= 1) { const int v = __shfl_up(x, d); if (lane >= d) x += v; }
        int take = need - (x - p); take = take < 0 ? 0 : (take > p ? p : take);
        unsigned m = an, r = 0u;
#pragma unroll 1
        for (int i = 0; i < take; ++i) { const unsigned lb = m & (0u - m); r |= lb; m ^= lb; }
        return bp_rotl<R>(sel, 4 * rot) | r;
    }
    return bp_rotl<R>(sel | alive, 4 * rot);
}
template <int R> __device__ __forceinline__ void store_sel(unsigned long long* MASKT, int b, int t, int lane, unsigned S) {
    if constexpr (R == 32) ((unsigned*)MASKT)[(((size_t)b * 32 + (lane >> 1)) * T + t) * 2 + (lane & 1)] = S;
    else if constexpr (R == 16) ((unsigned short*)MASKT)[(((size_t)b * 32 + (lane >> 2)) * T + t) * 4 + (lane & 3)] = (unsigned short)S;
    else if constexpr (R == 8) ((unsigned char*)MASKT)[(((size_t)b * 32 + (lane >> 3)) * T + t) * 8 + (lane & 7)] = (unsigned char)S;
    else {
#pragma unroll
        for (int i = 0; i < 3; ++i) { const int B = 3 * lane + i; ((unsigned char*)MASKT)[(((size_t)b * 32 + (B >> 3)) * T + t) * 8 + (B & 7)] = (unsigned char)(S >> (8 * i)); }
    }
    if constexpr (R < 32) { if (lane >= R && lane < 32) MASKT[((size_t)b * 32 + lane) * T + t] = 0ull; }
}

constexpr int DSA_S_OFF = 0;
__device__ __forceinline__ void indexer_unit(const bf16* QIDX, const bf16* KIDX, const float* WIDX, size_t tokb, int t0, LAS float* Sdst, int wave, int lane) {
    const int c = lane & 31, hi = lane >> 5;
    bf16x8 aq[4]; const int qq = c >> 2, hh = c & 3;
#pragma unroll
    for (int ks = 0; ks < 4; ++ks) aq[ks] = *(const bf16x8*)(QIDX + (tokb + t0 + qq) * 256 + hh * 64 + 16 * ks + 8 * hi);
    f32x4 wq[4];
#pragma unroll
    for (int jj = 0; jj < 4; ++jj) wq[jj] = *(const f32x4*)(WIDX + (tokb + t0 + 2 * jj + hi) * 4);
    const int ntiles = (t0 + 8 + 31) >> 5;
    const bf16* kb = KIDX + tokb * 64 + (size_t)hi * 256 + c * 8;
    bf16x8 kf[4], kn[4];
    if (wave < ntiles) {
#pragma unroll
        for (int ks = 0; ks < 4; ++ks) kf[ks] = *(const bf16x8*)(kb + (size_t)wave * 2048 + 512 * ks);
    }
#pragma unroll 1
    for (int tile = wave; tile < ntiles; tile += NWAVES) {
        const bool more = tile + NWAVES < ntiles;
        if (more) {
#pragma unroll
            for (int ks = 0; ks < 4; ++ks) kn[ks] = *(const bf16x8*)(kb + (size_t)(tile + NWAVES) * 2048 + 512 * ks);
        }
        f32x16 acc = {};
#pragma unroll
        for (int ks = 0; ks < 4; ++ks) acc = __builtin_amdgcn_mfma_f32_32x32x16_bf16(aq[ks], kf[ks], acc, 0, 0, 0);
        const int key = 32 * tile + c;
#pragma unroll
        for (int jj = 0; jj < 4; ++jj) { float sc = 0.f;
#pragma unroll
            for (int h = 0; h < 4; ++h) sc += wq[jj][h] * fmaxf(acc[4 * jj + h], 0.f);
            Sdst[(2 * jj + hi) * 2048 + key] = sc; }
        if (more) {
#pragma unroll
            for (int ks = 0; ks < 4; ++ks) kf[ks] = kn[ks];
        }
    }
}
constexpr int IDX_PRE = 6;
struct IdxRegs { bf16x8 aq[4]; f32x4 wq[4]; bf16x8 kf[IDX_PRE][4]; };
__device__ __forceinline__ void indexer_issue(const bf16* QIDX, const bf16* KIDX, const float* WIDX, size_t tokb, int t0, int wave, int lane, IdxRegs& r) {
    const int c = lane & 31, hi = lane >> 5, qq = c >> 2, hh = c & 3;
#pragma unroll
    for (int ks = 0; ks < 4; ++ks) r.aq[ks] = *(const bf16x8*)(QIDX + (tokb + t0 + qq) * 256 + hh * 64 + 16 * ks + 8 * hi);
#pragma unroll
    for (int jj = 0; jj < 4; ++jj) r.wq[jj] = *(const f32x4*)(WIDX + (tokb + t0 + 2 * jj + hi) * 4);
    const int ntiles = (t0 + 8 + 31) >> 5;
    const bf16* kb = KIDX + tokb * 64 + (size_t)hi * 256 + c * 8;
#pragma unroll
    for (int i = 0; i < IDX_PRE; ++i) { const int tile = wave + NWAVES * i;
        if (tile < ntiles) {
#pragma unroll
            for (int ks = 0; ks < 4; ++ks) r.kf[i][ks] = *(const bf16x8*)(kb + (size_t)tile * 2048 + 512 * ks); } }
}
__device__ __forceinline__ void indexer_tile(const IdxRegs& r, const bf16x8 (&kf)[4], int tile, LAS float* Sdst, int c, int hi) {
    f32x16 acc = {};
#pragma unroll
    for (int ks = 0; ks < 4; ++ks) acc = __builtin_amdgcn_mfma_f32_32x32x16_bf16(r.aq[ks], kf[ks], acc, 0, 0, 0);
    const int key = 32 * tile + c;
#pragma unroll
    for (int jj = 0; jj < 4; ++jj) { float sc = 0.f;
#pragma unroll
        for (int h = 0; h < 4; ++h) sc += r.wq[jj][h] * fmaxf(acc[4 * jj + h], 0.f);
        Sdst[(2 * jj + hi) * 2048 + key] = sc; }
}
__device__ __forceinline__ void indexer_compute(const IdxRegs& r, const bf16* KIDX, size_t tokb, int t0, LAS float* Sdst, int wave, int lane) {
    const int c = lane & 31, hi = lane >> 5;
    const int ntiles = (t0 + 8 + 31) >> 5;
    if constexpr (IDX_PRE < 8) if (ntiles > NWAVES * IDX_PRE) {
        const bf16* kb = KIDX + tokb * 64 + (size_t)hi * 256 + c * 8;
        bf16x8 k2[IDX_PRE < 8 ? 8 - IDX_PRE : 1][4];
#pragma unroll
        for (int i = IDX_PRE; i < 8; ++i) { const int tile = wave + NWAVES * i;
#pragma unroll
            for (int ks = 0; ks < 4; ++ks) k2[i - IDX_PRE][ks] = *(const bf16x8*)(kb + (size_t)tile * 2048 + 512 * ks); }
#pragma unroll
        for (int i = 0; i < IDX_PRE; ++i) indexer_tile(r, r.kf[i], wave + NWAVES * i, Sdst, c, hi);
#pragma unroll
        for (int i = IDX_PRE; i < 8; ++i) { const int tile = wave + NWAVES * i; if (tile < ntiles) indexer_tile(r, k2[i - IDX_PRE], tile, Sdst, c, hi); }
        return;
    }
    {
#pragma unroll
        for (int i = 0; i < IDX_PRE; ++i) { const int tile = wave + NWAVES * i; if (tile < ntiles) indexer_tile(r, r.kf[i], tile, Sdst, c, hi); }
    }
}
__device__ __forceinline__ void select_phase(Frame& F, const int mode) {
    { int t_ = F.wave0 * 64 + mk_lane(); asm volatile("" : "+v"(t_)); F.tid = t_; F.lane = t_ & 63; F.wave = __builtin_amdgcn_readfirstlane(t_ >> 6); }
    const int lane = F.lane, wave = F.wave;
    const bf16* QIDX = (const bf16*)(F.ws + WS_QIDX); const bf16* KIDX = (const bf16*)(F.ws + WS_KIDX); const float* WIDX = (const float*)(F.ws + WS_WIDX);
    unsigned long long* MASKT = (unsigned long long*)(F.ws + WS_MASKT);
    LAS float* S = (LAS float*)(F.lds + DSA_S_OFF);
    const int nunits = NB * (T / 8);
#define SEL_UNIT(u_, b_, t0_) const int b_ = (u_) >> 8; const int t0_ = ((((u_) & 255) + 16 * b_) & 255) * 8
    if (mode <= 1 && (int)blockIdx.x < nunits) { SEL_UNIT((int)blockIdx.x, b, t0); indexer_unit(QIDX, KIDX, WIDX, (size_t)b * T, t0, S, wave, lane); }
    __syncthreads();
    for (int i = 0; i * F.G + (int)blockIdx.x < nunits; ++i) {
        const int unit = i * F.G + (int)blockIdx.x;
#if MK_IDX_SPLIT
        int lane_u = F.lane; asm volatile("" : "+v"(lane_u));
        const bool has_next = mode <= 1 && unit + F.G < nunits;
        IdxRegs ir;
        if (has_next) { SEL_UNIT(unit + F.G, bn, t0n); indexer_issue(QIDX, KIDX, WIDX, (size_t)bn * T, t0n, wave, lane, ir); }
#else
        const bool idx_first = wave < 4;
        if (idx_first && mode <= 1 && unit + F.G < nunits) { SEL_UNIT(unit + F.G, bn, t0n); indexer_unit(QIDX, KIDX, WIDX, (size_t)bn * T, t0n, S + ((i + 1) & 1) * (8 * 2048), wave, lane); }
#endif
        SEL_UNIT(unit, b, t0);
        LAS float* Sw = S + (i & 1) * (8 * 2048) + wave * 2048;
        const int t = t0 + wave;
        unsigned long long myword = 0ull;
        if (mode != 1) {
#if MK_SEL_BP
        const bool st = (mode == 0 || mode == 3);
        const int lane = lane_u;
        if (t < 256) {
            if (lane < 32) { const int lo = 64 * lane; myword = t >= lo + 63 ? ~0ull : (t < lo ? 0ull : ((1ull << (t - lo + 1)) - 1ull)); if (st) MASKT[((size_t)b * 32 + lane) * T + t] = myword; }
        } else if (t < 512) { const unsigned Sb = select_bp<8>(Sw, t, lane); if (st) store_sel<8>(MASKT, b, t, lane, Sb); else asm volatile("" :: "v"(Sb)); }
        else if (t < 1024) { const unsigned Sb = select_bp<16>(Sw, t, lane); if (st) store_sel<16>(MASKT, b, t, lane, Sb); else asm volatile("" :: "v"(Sb)); }
        else if (t < 1536) { const unsigned Sb = select_bp<24>(Sw, t, lane); if (st) store_sel<24>(MASKT, b, t, lane, Sb); else asm volatile("" :: "v"(Sb)); }
        else { const unsigned Sb = select_bp<32>(Sw, t, lane); if (st) store_sel<32>(MASKT, b, t, lane, Sb); else asm volatile("" :: "v"(Sb)); }
#if MK_DEBUG
        { unsigned long long* MASKT2 = (unsigned long long*)(F.ws + WS_END); unsigned long long w2 = 0ull;
          if (t < 256) { if (lane < 32) { const int lo = 64 * lane; w2 = t >= lo + 63 ? ~0ull : (t < lo ? 0ull : ((1ull << (t - lo + 1)) - 1ull)); } }
          else if (t < 512) w2 = select_topk<8>(Sw, t, lane); else if (t < 1024) w2 = select_topk<16>(Sw, t, lane); else if (t < 1536) w2 = select_topk<24>(Sw, t, lane); else w2 = select_topk<32>(Sw, t, lane);
          if (lane < 32) MASKT2[((size_t)b * 32 + lane) * T + t] = w2; }
#endif
#else
        if (t < 256) {
            if (lane < 32) { const int lo = 64 * lane; myword = t >= lo + 63 ? ~0ull : (t < lo ? 0ull : ((1ull << (t - lo + 1)) - 1ull)); }
        } else if (t < 512) myword = select_topk<8>(Sw, t, lane);
        else if (t < 1024) myword = select_topk<16>(Sw, t, lane);
        else if (t < 1536) myword = select_topk<24>(Sw, t, lane);
        else myword = select_topk<32>(Sw, t, lane);
        if (mode == 2) asm volatile("" :: "v"(myword));
        if ((mode == 0 || mode == 3) && lane < 32) MASKT[((size_t)b * 32 + lane) * T + t] = myword;
#endif
        }
#if MK_IDX_SPLIT
        if (has_next) { SEL_UNIT(unit + F.G, bn2, t0n); indexer_compute(ir, KIDX, (size_t)bn2 * T, t0n, S + ((i + 1) & 1) * (8 * 2048), wave, lane); }
#else
        if (!idx_first && mode <= 1 && unit + F.G < nunits) { SEL_UNIT(unit + F.G, bn, t0n); indexer_unit(QIDX, KIDX, WIDX, (size_t)bn * T, t0n, S + ((i + 1) & 1) * (8 * 2048), wave, lane); }
#endif
        __syncthreads();
    }
#undef SEL_UNIT
}

constexpr int ATT_KB = 0, ATT_VB = 32768;
constexpr int ATT_LUT = 65536;
__device__ __forceinline__ float lane_half_max(float v) {
    const auto rr = __builtin_amdgcn_permlane32_swap(__builtin_bit_cast(unsigned, v), __builtin_bit_cast(unsigned, v), false, false);
    return fmaxf(__builtin_bit_cast(float, rr[0]), __builtin_bit_cast(float, rr[1]));
}
__device__ __forceinline__ void attn_phase(Frame& F) {
    int tid; { int t_ = F.wave0 * 64 + mk_lane(); asm volatile("" : "+v"(t_)); tid = t_; }
    const int lane = tid & 63, wave = __builtin_amdgcn_readfirstlane(tid >> 6), r32 = lane & 31, hi = lane >> 5;
    const bf16* Q = (const bf16*)(F.ws + WS_Q); const bf16* KP = (const bf16*)(F.ws + WS_KP); const bf16* VPT = (const bf16*)(F.ws + WS_VP);
    const unsigned long long* MASKT = (const unsigned long long*)(F.ws + WS_MASKT);
    bf16* ACT = (bf16*)(F.ws + WS_ACT);
    const int srow = tid >> 3, sch = tid & 7;
    const unsigned kdst = (unsigned)(srow * 128 + ((sch ^ ((srow >> 1) & 7)) << 4));
    const unsigned vdst0 = (unsigned)(srow * 128 + ((((sch >> 1) * 2) ^ ((srow >> 1) & 7)) << 4) + 8 * (sch & 1));
    const unsigned vdst1 = (unsigned)(srow * 128 + ((((sch >> 1) * 2 + 1) ^ ((srow >> 1) & 7)) << 4) + 8 * (sch & 1));
    const unsigned frow = (unsigned)(r32 * 128), fsw = (unsigned)((r32 >> 1) & 7);
    const int nunits = NB * 8 * 4;
    if (tid < 16) { const unsigned lo = ((tid & 1) ? 0xffffu : 0u) | ((tid & 2) ? 0xffff0000u : 0u), hi2 = ((tid & 4) ? 0xffffu : 0u) | ((tid & 8) ? 0xffff0000u : 0u);
        *(LAS unsigned long long*)(F.lds + ATT_LUT + 8 * tid) = (unsigned long long)lo | ((unsigned long long)hi2 << 32); }
    __syncthreads();
    for (int it = 0; ; ++it) {
        int bh, qb;
        if (F.G == 256) { if (it >= 2) break; bh = (int)blockIdx.x >> 1; qb = ((int)blockIdx.x & 1) ? (it == 0 ? 2 : 1) : (it == 0 ? 3 : 0); }
        else { const int uid = it * F.G + (int)blockIdx.x; if (uid >= nunits) break; bh = uid >> 2; qb = uid & 3; }
        const int b = bh >> 3, h = bh & 7, q0 = qb * 512; const size_t tokb = (size_t)b * T;
        const int qrowA = q0 + wave * 64 + r32;
        bf16x8 qf[2][4];
#pragma unroll
        for (int qq = 0; qq < 2; ++qq)
#pragma unroll
            for (int ks = 0; ks < 4; ++ks) qf[qq][ks] = *(const bf16x8*)((const char*)(Q + (tokb + q0 + wave * 64 + 32 * qq) * 512 + h * 64 + 16 * ks) + (unsigned)(r32 * 512 + 8 * hi) * 2u);
        f32x16 o[2][2]; o[0][0] = f32x16{}; o[0][1] = f32x16{}; o[1][0] = f32x16{}; o[1][1] = f32x16{};
        float m[2] = {0.f, 0.f}, l[2] = {0.f, 0.f};
        const int nst = 4 * (qb + 1), wlast = (q0 + wave * 64 + 63) >> 6;
        const char* kbase = (const char*)(KP + tokb * 512 + h * 64); const char* vbase = (const char*)(VPT + (size_t)(h * 64) * NT + tokb);
        const char* mbase = (const char*)(MASKT + (size_t)b * 32 * T + q0 + wave * 64);
        const unsigned klane = (unsigned)(srow * 512 + 8 * sch) * 2u, vlane = (unsigned)(srow * NT + 8 * sch) * 2u, mlane = (unsigned)r32 * 8u;
#define ATT_KLD(ko_) (*(const v4u*)(kbase + (size_t)(ko_) * 1024 + klane))
#define ATT_VLD(ko_) (*(const v4u*)(vbase + (size_t)(ko_) * 2 + vlane))
#define ATT_MLD(j_, q_) (*(const unsigned long long*)(mbase + ((size_t)(j_) * T + 32 * (q_)) * 8 + mlane))
        v4u kr0 = ATT_KLD(0), kr1 = ATT_KLD(64), vr0 = ATT_VLD(0), vr1 = ATT_VLD(64);
        unsigned long long mw[2][2];
        mw[0][0] = ATT_MLD(0, 0); mw[0][1] = ATT_MLD(0, 1); mw[1][0] = ATT_MLD(1, 0); mw[1][1] = ATT_MLD(1, 1);
#define ATT_STAGE_WRITE(boff_) do { \
        *(LAS v4u*)(F.lds + ATT_KB + (boff_) + kdst) = kr0; *(LAS v4u*)(F.lds + ATT_KB + (boff_) + 8192 + kdst) = kr1; \
        *(LAS unsigned long long*)(F.lds + ATT_VB + (boff_) + vdst0) = (unsigned long long)vr0.x | ((unsigned long long)vr0.y << 32); \
        *(LAS unsigned long long*)(F.lds + ATT_VB + (boff_) + vdst1) = (unsigned long long)vr0.z | ((unsigned long long)vr0.w << 32); \
        *(LAS unsigned long long*)(F.lds + ATT_VB + (boff_) + 8192 + vdst0) = (unsigned long long)vr1.x | ((unsigned long long)vr1.y << 32); \
        *(LAS unsigned long long*)(F.lds + ATT_VB + (boff_) + 8192 + vdst1) = (unsigned long long)vr1.z | ((unsigned long long)vr1.w << 32); } while (0)
        ATT_STAGE_WRITE(0u);
        __syncthreads();
#pragma unroll 1
        for (int st = 0; st < nst; ++st) {
            const unsigned boff = (unsigned)(st & 1) * 16384u;
#if MK_ATT_SKEW
            if (wave >= 4) __builtin_amdgcn_s_sleep(MK_ATT_SKEW);
#endif
            unsigned long long mn[2][2] = {{0ull, 0ull}, {0ull, 0ull}};
            if (st + 1 < nst) { const size_t ko = (size_t)(st + 1) * 128;
                kr0 = ATT_KLD(ko); kr1 = ATT_KLD(ko + 64); vr0 = ATT_VLD(ko); vr1 = ATT_VLD(ko + 64);
                mn[0][0] = ATT_MLD(2 * st + 2, 0); mn[0][1] = ATT_MLD(2 * st + 2, 1); mn[1][0] = ATT_MLD(2 * st + 3, 0); mn[1][1] = ATT_MLD(2 * st + 3, 1); }
#pragma unroll
            for (int sub = 0; sub < 2; ++sub) {
                const int j = 2 * st + sub;
                if (j <= wlast) {
                    const unsigned so = boff + (unsigned)sub * 8192u;
                    f32x16 p[2][2]; p[0][0] = f32x16{}; p[0][1] = f32x16{}; p[1][0] = f32x16{}; p[1][1] = f32x16{};
#pragma unroll
                    for (int ks = 0; ks < 4; ++ks) {
                        const unsigned ch = (((unsigned)(2 * ks + hi)) ^ fsw) << 4;
                        const bf16x8 k0 = *(const LAS bf16x8*)(F.lds + ATT_KB + so + frow + ch), k1 = *(const LAS bf16x8*)(F.lds + ATT_KB + so + frow + 4096 + ch);
#pragma unroll
                        for (int qq = 0; qq < 2; ++qq) { p[qq][0] = __builtin_amdgcn_mfma_f32_32x32x16_bf16(k0, qf[qq][ks], p[qq][0], 0, 0, 0); p[qq][1] = __builtin_amdgcn_mfma_f32_32x32x16_bf16(k1, qf[qq][ks], p[qq][1], 0, 0, 0); }
                    }
#pragma unroll
                    for (int qq = 0; qq < 2; ++qq) {
                        const float mold = m[qq];
#pragma unroll
                        for (int r = 0; r < 16; ++r) { p[qq][0][r] -= mold; p[qq][1][r] -= mold; }
                        float mx = fmaxf(p[qq][0][0], p[qq][1][0]);
#pragma unroll
                        for (int r = 1; r < 16; ++r) mx = fmaxf(mx, fmaxf(p[qq][0][r], p[qq][1][r]));
                        mx = lane_half_max(mx);
                        if (j == 0 || __any(mx > ATT_THR)) {
                            const float dl = j == 0 ? mx : fmaxf(mx, 0.f), al = __builtin_amdgcn_exp2f(-dl);
                            m[qq] += dl; l[qq] *= al;
#pragma unroll
                            for (int r = 0; r < 16; ++r) { o[qq][0][r] *= al; o[qq][1][r] *= al; p[qq][0][r] -= dl; p[qq][1][r] -= dl; }
                        }
#pragma unroll
                        for (int r = 0; r < 16; ++r) { p[qq][0][r] = __builtin_amdgcn_exp2f(p[qq][0][r]); p[qq][1][r] = __builtin_amdgcn_exp2f(p[qq][1][r]); }
                    }
#pragma unroll
                    for (int s = 0; s < 4; ++s) {
                        const unsigned ch = (((unsigned)(2 * s + hi)) ^ fsw) << 4;
                        const bf16x8 v0 = *(const LAS bf16x8*)(F.lds + ATT_VB + so + frow + ch), v1 = *(const LAS bf16x8*)(F.lds + ATT_VB + so + frow + 4096 + ch);
#pragma unroll
                        for (int qq = 0; qq < 2; ++qq) {
                            v4u pw; const int hb = s >> 1, s2 = s & 1;
                            const unsigned m3 = (((unsigned)(mw[sub][qq] >> (32 * hb + 4 * hi))) & 0x0f0f0f0fu) << 3;
                            const unsigned long long pm0 = *(const LAS unsigned long long*)(F.lds + ATT_LUT + __builtin_amdgcn_ubfe(m3, 16 * s2, 7)), pm1 = *(const LAS unsigned long long*)(F.lds + ATT_LUT + __builtin_amdgcn_ubfe(m3, 16 * s2 + 8, 7));
                            pw.x = pg8::cvt_pk_bf16(p[qq][hb][8 * s2 + 0], p[qq][hb][8 * s2 + 1]) & (unsigned)pm0; pw.y = pg8::cvt_pk_bf16(p[qq][hb][8 * s2 + 2], p[qq][hb][8 * s2 + 3]) & (unsigned)(pm0 >> 32);
                            pw.z = pg8::cvt_pk_bf16(p[qq][hb][8 * s2 + 4], p[qq][hb][8 * s2 + 5]) & (unsigned)pm1; pw.w = pg8::cvt_pk_bf16(p[qq][hb][8 * s2 + 6], p[qq][hb][8 * s2 + 7]) & (unsigned)(pm1 >> 32);
                            l[qq] = dot2_ones(pw.x, l[qq]); l[qq] = dot2_ones(pw.y, l[qq]); l[qq] = dot2_ones(pw.z, l[qq]); l[qq] = dot2_ones(pw.w, l[qq]);
                            const bf16x8 pf = __builtin_bit_cast(bf16x8, pw);
                            o[qq][0] = __builtin_amdgcn_mfma_f32_32x32x16_bf16(v0, pf, o[qq][0], 0, 0, 0);
                            o[qq][1] = __builtin_amdgcn_mfma_f32_32x32x16_bf16(v1, pf, o[qq][1], 0, 0, 0);
                        }
                        __builtin_amdgcn_sched_barrier(0);
                    }
                }
            }
            if (st + 1 < nst) { const unsigned nb = (unsigned)((st + 1) & 1) * 16384u; ATT_STAGE_WRITE(nb); }
#pragma unroll
            for (int a = 0; a < 2; ++a)
#pragma unroll
                for (int c = 0; c < 2; ++c) mw[a][c] = mn[a][c];
            __syncthreads();
        }
#undef ATT_STAGE_WRITE
#undef ATT_KLD
#undef ATT_VLD
#undef ATT_MLD
#pragma unroll
        for (int qq = 0; qq < 2; ++qq) {
            float lt = l[qq]; lt += __shfl_xor(lt, 32);
            const float rl = 1.0f / lt;
            int lo_ = lane; asm volatile("" : "+v"(lo_));
            bf16* orow = (bf16*)((char*)(ACT + (tokb + q0 + wave * 64 + 32 * qq) * 1536 + h * 64) + (unsigned)((lo_ & 31) * 1536 + 4 * (lo_ >> 5)) * 2u);
#pragma unroll
            for (int g4 = 0; g4 < 4; ++g4) {
                *(unsigned long long*)(orow + 8 * g4) = (unsigned long long)pk2(o[qq][0][4 * g4] * rl, o[qq][0][4 * g4 + 1] * rl) | ((unsigned long long)pk2(o[qq][0][4 * g4 + 2] * rl, o[qq][0][4 * g4 + 3] * rl) << 32);
                *(unsigned long long*)(orow + 32 + 8 * g4) = (unsigned long long)pk2(o[qq][1][4 * g4] * rl, o[qq][1][4 * g4 + 1] * rl) | ((unsigned long long)pk2(o[qq][1][4 * g4 + 2] * rl, o[qq][1][4 * g4 + 3] * rl) << 32);
            }
        }
    }
}

constexpr int N_PHASES = 15;
struct Args { const float* in[31]; float* out; unsigned char* ws; int ph_lo, ph_hi; };
__global__ void __launch_bounds__(NWAVES * 64, 2) mk_fwd(Args args) {
    extern __shared__ __attribute__((aligned(16))) unsigned char lds[];
    Frame F;
    F.lds = (LAS unsigned char*)lds;
    F.tid = threadIdx.x; F.lane = F.tid & 63; F.wave = __builtin_amdgcn_readfirstlane(F.tid >> 6); F.wave0 = F.wave; F.G = gridDim.x;
#pragma unroll
    for (int i = 0; i < 31; ++i) F.in[i] = args.in[i];
    F.out = args.out; F.ws = args.ws;
    unsigned char* ws = args.ws;
    for (int u = F.tid; u < (LDS_BYTES - LDSCTL_OFF) / 4; u += NWAVES * 64) ((LAS unsigned*)(F.lds + LDSCTL_OFF))[u] = 0u;
    __syncthreads();
#if MK_ONE_LAUNCH
    cooperative_groups::grid_group grid = cooperative_groups::this_grid();
    XcdBarrier bar = xcd_barrier_post((unsigned*)(ws + WS_CTL) + CW_BAR, (volatile LAS unsigned*)(F.lds + MISC_OFF) + 8, (unsigned)F.wave0);
    if (args.ph_lo < 0) grid.sync();
#define SEAM(k) do { xcd_barrier(bar); } while (0)
#else
#define SEAM(k) do { } while (0)
#endif
    const int lo = args.ph_lo, hi = args.ph_hi;
#define IN(k) ((((MK_PHMASK) >> (k)) & 1) && lo <= (k) && (k) < hi)
#define BOTH(k) (IN(k) && IN((k) + 1))
    typedef pg8::bf16_t bt;
    bt* H = (bt*)(ws + WS_H); bt* Y = (bt*)(ws + WS_Y); bt* HID = (bt*)(ws + WS_BIG); bt* ACT = (bt*)(ws + WS_ACT);
    float* RS1 = (float*)(ws + WS_RS); float* RS2 = RS1 + NT;
    bt* MERGED = (bt*)F.out;
    const int bid = (int)blockIdx.x;

#define REPS(k) ((k) == MK_REP_PHASE ? 2 : 1)
    if (IN(0)) { for (int rep = 0; rep < REPS(0); ++rep) { p0_prologue(F); if (rep + 1 < REPS(0)) SEAM(0); } if (BOTH(0)) SEAM(0); }
    if (IN(1)) { for (int rep = 0; rep < REPS(1); ++rep) {
        const bool early = ((bid >> 3) & 1) == 0;
        if (early) repack_jobs(F, 1, 16);
        { pg8::Gemm g{H, (const bt*)(ws + WS_WGU1), NT, 5632, 1024, 1024, 1024}; g.w0 = F.wave0; pg8::StaticOrder S; S.init(NT, 5632, F.G, bid); pg8::EpiSwiglu E{HID, FF};
          pg8::gemm_phase<pg8::EpiSwiglu, pg8::StaticOrder, MK_ALIGN, MK_SP2>(F.lds, g, S, E); }
        if (!early) repack_jobs(F, 1, 16);
        if (rep + 1 < REPS(1)) SEAM(1); } if (BOTH(1)) SEAM(1);
    }
    if (IN(2)) { for (int rep = 0; rep < REPS(2); ++rep) {
        pg8::Gemm g{HID, (const bt*)(ws + WS_WDN1), NT, 1024, FF, FF, FF}; g.w0 = F.wave0; pg8::StaticOrder S; S.init(NT, 1024, F.G, bid); pg8::EpiSplit E{Y, 1024, 1 << 20, nullptr, 0, 1.f, 1.f};
        pg8::gemm_phase<pg8::EpiSplit, pg8::StaticOrder, MK_ALIGN, MK_SP2>(F.lds, g, S, E);
        if (rep + 1 < REPS(2)) SEAM(2); } if (BOTH(2)) SEAM(2);
    }
    if (IN(3)) { for (int rep = 0; rep < REPS(3); ++rep) { ew_phase<2, 2>(F, (const bf16*)Y, (const bf16*)H, RS1 + 2 * NT, F.in[3], 0.5f, nullptr, (bf16*)H, RS1);     if (rep + 1 < REPS(3)) SEAM(3); } if (BOTH(3)) SEAM(3); }
    if (IN(4)) { for (int rep = 0; rep < REPS(4); ++rep) {
        pg8::Gemm g{H, (const bt*)(ws + WS_WIN), NT, 2304, 1024, 1024, 1024}; g.w0 = F.wave0; pg8::StaticOrder S; S.init(NT, 2304, F.G, bid);
        pg8::EpiWinA E{(bt*)(ws + WS_CQ), (bt*)(ws + WS_CKV), (float*)(ws + WS_KW), Y, Y + (size_t)NT * 512, F.in[10], 0.08838834764831845f * LOG2E, (PG8_LAS float*)(F.lds + RED_OFF)};
        pg8::gemm_phase<pg8::EpiWinA, pg8::StaticOrder, true, MK_SP2>(F.lds, g, S, E);
        { const int cm = F.G == 256 ? bid - 128 : bid;
          if (cm >= 0 && cm < 32) { pg8::Gemm g{(const bt*)(ws + WS_MEMN), (const bt*)(ws + WS_WMK), NB * NMEM, 512, 1024, 1024, 1024}; g.w0 = F.wave0; pg8::StaticOrder S; S.init(NB * NMEM, 512, 1 << 20, cm);
            pg8::EpiSplit E{(bt*)(ws + WS_MK), 512, 1 << 20, nullptr, 0, 1.f, 1.f}; pg8::gemm_phase<pg8::EpiSplit, pg8::StaticOrder, MK_ALIGN, MK_SP2>(F.lds, g, S, E); }
          const int cv = F.G == 256 ? bid - 160 : bid - 32;
          if (cv >= 0 && cv < 32) { pg8::Gemm g{(const bt*)(ws + WS_WMV), (const bt*)(ws + WS_MEMN), 512, NB * NMEM, 1024, 1024, 1024}; g.w0 = F.wave0; pg8::StaticOrder S; S.init(512, NB * NMEM, 1 << 20, cv);
            pg8::EpiSplit E{(bt*)(ws + WS_MVT), NB * NMEM, 1 << 20, nullptr, 0, 1.f, 1.f}; pg8::gemm_phase<pg8::EpiSplit, pg8::StaticOrder, MK_ALIGN, MK_SP2>(F.lds, g, S, E); } }
        if (rep + 1 < REPS(4)) SEAM(4); } if (BOTH(4)) SEAM(4);
    }
    if (IN(5)) { for (int rep = 0; rep < REPS(5); ++rep) { const int p5m = rep == 0 ? MK_P5MASK : MK_REP_MODE;
        if (p5m & 1) { pg8::Gemm g{(const bt*)(ws + WS_CQ), (const bt*)(ws + WS_WQ), NT, 768, 256, 256, 256}; g.w0 = F.wave0; pg8::StaticOrder S; S.init(NT, 768, F.G, bid);
          pg8::EpiSplit E{(bt*)(ws + WS_Q), 512, 2, (bt*)(ws + WS_QIDX), 256, 1.f, 1.f}; pg8::gemm_phase<pg8::EpiSplit, pg8::StaticOrder, MK_ALIGN, MK_SP2>(F.lds, g, S, E); }
        if (p5m & 2) { pg8::Gemm g{(const bt*)(ws + WS_CKV), (const bt*)(ws + WS_WKV), NT, 512, 256, 256, 256}; g.w0 = F.wave0; pg8::StaticOrder S; S.init(NT, 512, F.G, bid);
          pg8::EpiSplit E{(bt*)(ws + WS_KP), 512, 1 << 20, nullptr, 0, 1.f, 1.f}; pg8::gemm_phase<pg8::EpiSplit, pg8::StaticOrder, MK_ALIGN, MK_SP2>(F.lds, g, S, E); }
        if (p5m & 2) { pg8::Gemm g{(const bt*)(ws + WS_WKV) + (size_t)512 * 256, (const bt*)(ws + WS_CKV), 512, NT, 256, 256, 256}; g.w0 = F.wave0; pg8::StaticOrder S; S.init(512, NT, F.G, bid);
          pg8::EpiSplit E{(bt*)(ws + WS_VP), NT, 1 << 20, nullptr, 0, 1.f, 1.f}; pg8::gemm_phase<pg8::EpiSplit, pg8::StaticOrder, MK_ALIGN, MK_SP2>(F.lds, g, S, E); }
        if (p5m & 4) kidx_phase(F);
        if (p5m & 8) conv_phase(F);
        if (p5m & 16) memattn_phase(F);
        if (rep + 1 < REPS(5)) SEAM(5); } if (BOTH(5)) SEAM(5);
    }
    if (IN(6)) { for (int rep = 0; rep < REPS(6); ++rep) { select_phase(F, rep == 0 ? 0 : MK_REP_MODE); if (rep + 1 < REPS(6)) SEAM(6); } if (BOTH(6)) SEAM(6); }
    if (IN(7)) { for (int rep = 0; rep < REPS(7); ++rep) { attn_phase(F); if (rep + 1 < REPS(7)) SEAM(7); } if (BOTH(7)) SEAM(7); }
    if (IN(8)) { for (int rep = 0; rep < REPS(8); ++rep) {
        pg8::Gemm g{H, (const bt*)(ws + WS_WIN) + (size_t)2304 * 1024, NT, 3072, 1024, 1024, 1024}; g.w0 = F.wave0; pg8::StaticOrder S; S.init(NT, 3072, F.G, bid); pg8::EpiGates E{HID, 3072};
        pg8::gemm_phase<pg8::EpiGates, pg8::StaticOrder, MK_ALIGN, MK_SP2>(F.lds, g, S, E);
        if (rep + 1 < REPS(8)) SEAM(8); } if (BOTH(8)) SEAM(8);
    }
    if (IN(9)) { for (int rep = 0; rep < REPS(9); ++rep) {
        pg8::Gemm g{ACT, (const bt*)(ws + WS_WCAT), NT, 1024, 512, 1536, 1536}; g.w0 = F.wave0; pg8::MergeOrder S; S.base.init(NT, 1024, F.G, bid); pg8::EpiMerge E{HID, MERGED};
        pg8::gemm_phase<pg8::EpiMerge, pg8::MergeOrder, MK_ALIGN, MK_SP2>(F.lds, g, S, E);
        if (rep + 1 < REPS(9)) SEAM(9); } if (BOTH(9)) SEAM(9);
    }
    if (IN(10)) { for (int rep = 0; rep < REPS(10); ++rep) {
        pg8::Gemm g{MERGED, (const bt*)(ws + WS_WOUT), NT, 1024, 1024, 1024, 1024}; g.w0 = F.wave0; pg8::StaticOrder S; S.init(NT, 1024, F.G, bid); pg8::EpiSplit E{Y, 1024, 1 << 20, nullptr, 0, 1.f, 1.f};
        pg8::gemm_phase<pg8::EpiSplit, pg8::StaticOrder, MK_ALIGN, MK_SP2>(F.lds, g, S, E);
        if (rep + 1 < REPS(10)) SEAM(10); } if (BOTH(10)) SEAM(10);
    }
    if (IN(11)) { for (int rep = 0; rep < REPS(11); ++rep) { ew_phase<2, 2>(F, (const bf16*)Y, (const bf16*)H, RS1, F.in[7], 1.0f, nullptr, (bf16*)H, RS2);     if (rep + 1 < REPS(11)) SEAM(11); } if (BOTH(11)) SEAM(11); }
    if (IN(12)) { for (int rep = 0; rep < REPS(12); ++rep) {
        pg8::Gemm g{H, (const bt*)(ws + WS_WGU2), NT, 5632, 1024, 1024, 1024}; g.w0 = F.wave0; pg8::StaticOrder S; S.init(NT, 5632, F.G, bid); pg8::EpiSwiglu E{HID, FF};
        pg8::gemm_phase<pg8::EpiSwiglu, pg8::StaticOrder, MK_ALIGN, MK_SP2>(F.lds, g, S, E);
        if (rep + 1 < REPS(12)) SEAM(12); } if (BOTH(12)) SEAM(12);
    }
    if (IN(13)) { for (int rep = 0; rep < REPS(13); ++rep) {
        pg8::Gemm g{HID, (const bt*)(ws + WS_WDN2), NT, 1024, FF, FF, FF}; g.w0 = F.wave0; pg8::StaticOrder S; S.init(NT, 1024, F.G, bid); pg8::EpiSplit E{Y, 1024, 1 << 20, nullptr, 0, 1.f, 1.f};
        pg8::gemm_phase<pg8::EpiSplit, pg8::StaticOrder, MK_ALIGN, MK_SP2>(F.lds, g, S, E);
        if (rep + 1 < REPS(13)) SEAM(13); } if (BOTH(13)) SEAM(13);
    }
    if (IN(14)) { ew_phase<2, 0>(F, (const bf16*)Y, (const bf16*)H, RS2, F.in[28], 0.5f, F.out, nullptr, nullptr); }
#undef IN
#undef BOTH
}

#if MK_DEBUG
constexpr int DBG_W = 2048;
__device__ __forceinline__ float blk_sum(float v, float* sh) {
    v = wave_sum(v); __syncthreads(); if ((threadIdx.x & 63) == 0) sh[threadIdx.x >> 6] = v; __syncthreads();
    float t = 0.f; for (int i = 0; i < 8; ++i) t += sh[i]; __syncthreads(); return t;
}
__device__ __forceinline__ void dbg_report(unsigned char* ws, int slot, float err2, float ref2) {
    if (threadIdx.x == 0) { const float rel = sqrtf(err2 / fmaxf(ref2, 1e-30f)); atomicMax((unsigned*)ws + DBG_W + slot, __builtin_bit_cast(unsigned, rel)); if (rel > 0.03f) atomicAdd((unsigned*)ws + DBG_W + 8 + slot, 1u); }
}
__device__ __forceinline__ int dbg_row(int i) { return (int)(((unsigned)i * 2654435761u) % (unsigned)NT); }
__global__ void __launch_bounds__(512) dbg_ffn(const float* xin, const float* gpre, const float* wgu, const float* wdn, const unsigned short* Y, unsigned char* ws, int slot) {
    __shared__ float h[1024]; __shared__ float hid[2816]; __shared__ float sh[8];
    const int r = dbg_row(blockIdx.x), tid = threadIdx.x;
    float s = 0.f; for (int k = tid; k < 1024; k += 512) { const float v = xin[(size_t)r * 1024 + k]; s += v * v; }
    s = blk_sum(s, sh); const float rstd = 1.0f / sqrtf(s / 1024.f + 1e-6f);
    for (int k = tid; k < 1024; k += 512) h[k] = xin[(size_t)r * 1024 + k] * rstd * gpre[k];
    __syncthreads();
    for (int j = tid; j < 2816; j += 512) { float g = 0.f, u = 0.f; for (int k = 0; k < 1024; ++k) { g += h[k] * wgu[(size_t)k * 5632 + j]; u += h[k] * wgu[(size_t)k * 5632 + 2816 + j]; }
        hid[j] = g / (1.f + expf(-g)) * u; }
    __syncthreads();
    float e2 = 0.f, r2 = 0.f;
    for (int n = tid; n < 1024; n += 512) { float y = 0.f; for (int j = 0; j < 2816; ++j) y += hid[j] * wdn[(size_t)j * 1024 + n];
        const float d = y - bf2f(Y[(size_t)r * 1024 + n]); e2 += d * d; r2 += y * y; }
    e2 = blk_sum(e2, sh); r2 = blk_sum(r2, sh); dbg_report(ws, slot, e2, r2);
}
__global__ void __launch_bounds__(512) dbg_ew(const float* xin, const unsigned short* Y, const float* gain, float coef, const float* xout, const unsigned short* H, unsigned char* ws, int slot) {
    __shared__ float sh[8];
    const int r = dbg_row(blockIdx.x), tid = threadIdx.x;
    float s = 0.f; for (int k = tid; k < 1024; k += 512) { const float v = bf2f(Y[(size_t)r * 1024 + k]); s += v * v; }
    s = blk_sum(s, sh); const float rstd = 1.0f / sqrtf(s / 1024.f + 1e-6f);
    float xn[2]; float s2 = 0.f; float e2 = 0.f, r2 = 0.f;
    for (int i = 0; i < 2; ++i) { const int k = tid + 512 * i; xn[i] = xin[(size_t)r * 1024 + k] + coef * gain[k] * bf2f(Y[(size_t)r * 1024 + k]) * rstd; s2 += xn[i] * xn[i];
        const float d = xn[i] - xout[(size_t)r * 1024 + k]; e2 += d * d; r2 += xn[i] * xn[i]; }
    s2 = blk_sum(s2, sh); const float r2d = 1.0f / sqrtf(s2 / 1024.f + 1e-6f);
    if (H) for (int i = 0; i < 2; ++i) { const int k = tid + 512 * i; const float hv = xn[i] * r2d; const float d = hv - bf2f(H[(size_t)r * 1024 + k]); e2 += d * d; r2 += hv * hv; }
    e2 = blk_sum(e2, sh); r2 = blk_sum(r2, sh); dbg_report(ws, slot, e2, r2);
}
__global__ void __launch_bounds__(512) dbg_conv(const unsigned short* H, const float* gpre, const float* win, const float* wdw, const float* bdw, const float* lng, const float* lnb, const unsigned short* ACT, unsigned char* ws, int slot) {
    __shared__ float hrow[1024]; __shared__ float sh[8];
    const int t = dbg_row(blockIdx.x), tid = threadIdx.x, tb = t % T;
    float y = bdw[tid];
    for (int j = 0; j < 31; ++j) { const int p = tb - 30 + j; if (p < 0) continue;
        const int s = t - 30 + j;
        __syncthreads();
        for (int k = tid; k < 1024; k += 512) hrow[k] = bf2f(H[(size_t)s * 1024 + k]) * gpre[k];
        __syncthreads();
        float a = 0.f, g = 0.f; for (int k = 0; k < 1024; ++k) { a += hrow[k] * win[(size_t)k * 5188 + 580 + tid]; g += hrow[k] * win[(size_t)k * 5188 + 1092 + tid]; }
        y += wdw[j * 512 + tid] * (a / (1.f + expf(-g))); }
    const float mean = blk_sum(y, sh) / 512.f; const float xc = y - mean; const float var = blk_sum(xc * xc, sh) / 512.f;
    float v = xc / sqrtf(var + 1e-6f) * lng[tid] + lnb[tid]; v = v / (1.f + expf(-v));
    const float d = v - bf2f(ACT[(size_t)t * 1536 + 512 + tid]);
    const float e2 = blk_sum(d * d, sh), r2 = blk_sum(v * v, sh); dbg_report(ws, slot, e2, r2);
}

__global__ void __launch_bounds__(512) dbg_merge(const unsigned short* ACT, const unsigned short* G, const float* wa, const float* wb, const float* wm, const unsigned short* Hm, unsigned char* ws, int slot) {
    __shared__ float arow[1536]; __shared__ float sh[8];
    const int r = dbg_row(blockIdx.x), tid = threadIdx.x;
    for (int k = tid; k < 1536; k += 512) arow[k] = bf2f(ACT[(size_t)r * 1536 + k]);
    __syncthreads();
    float e2 = 0.f, r2 = 0.f;
    for (int n = tid; n < 1024; n += 512) { float ya = 0.f, yb = 0.f, ym = 0.f;
        for (int k = 0; k < 512; ++k) { ya += arow[k] * wa[(size_t)k * 1024 + n]; yb += arow[512 + k] * wb[(size_t)k * 1024 + n]; ym += arow[1024 + k] * wm[(size_t)k * 1024 + n]; }
        const float v = bf2f(G[(size_t)r * 3072 + n]) * ya + bf2f(G[(size_t)r * 3072 + 1024 + n]) * yb + bf2f(G[(size_t)r * 3072 + 2048 + n]) * ym;
        const float d = v - bf2f(Hm[(size_t)r * 1024 + n]); e2 += d * d; r2 += v * v; }
    e2 = blk_sum(e2, sh); r2 = blk_sum(r2, sh); dbg_report(ws, slot, e2, r2);
}
__global__ void __launch_bounds__(512) dbg_gemm(const unsigned short* A, int K, const float* W, const unsigned short* O, unsigned char* ws, int slot) {
    __shared__ float arow[2816]; __shared__ float sh[8];
    const int r = dbg_row(blockIdx.x), tid = threadIdx.x;
    for (int k = tid; k < K; k += 512) arow[k] = bf2f(A[(size_t)r * K + k]);
    __syncthreads();
    float e2 = 0.f, r2 = 0.f;
    for (int n = tid; n < 1024; n += 512) { float y = 0.f; for (int k = 0; k < K; ++k) y += arow[k] * W[(size_t)k * 1024 + n];
        const float d = y - bf2f(O[(size_t)r * 1024 + n]); e2 += d * d; r2 += y * y; }
    e2 = blk_sum(e2, sh); r2 = blk_sum(r2, sh); dbg_report(ws, slot, e2, r2);
}
__global__ void dbg_force(unsigned char* ws, int slot) { if (threadIdx.x == 0 && blockIdx.x == 0) ((unsigned*)ws)[DBG_W + slot] = __builtin_bit_cast(unsigned, 1.0f); }

__global__ void __launch_bounds__(512) dbg_lin(const unsigned short* A, int lda, int K, const float* ascale, const float* W, int ldw, int coff, int N, const unsigned short* O, long o_rs, long o_cs, float oscale, int act, int nrows, unsigned char* ws, int slot) {
    __shared__ float arow[1024]; __shared__ float sh[8];
    const int r = (int)(((unsigned)blockIdx.x * 2654435761u) % (unsigned)nrows), tid = threadIdx.x;
    for (int k = tid; k < K; k += 512) arow[k] = bf2f(A[(size_t)r * lda + k]) * (ascale ? ascale[k] : 1.f);
    __syncthreads();
    float e2 = 0.f, r2 = 0.f;
    for (int n = tid; n < N; n += 512) { float y = 0.f; for (int k = 0; k < K; ++k) y += arow[k] * W[(size_t)k * ldw + coff + n];
        y *= oscale; if (act == 1) y = 1.f / (1.f + expf(-y));
        const float dd = y - bf2f(O[(size_t)r * o_rs + (size_t)n * o_cs]); e2 += dd * dd; r2 += y * y; }
    e2 = blk_sum(e2, sh); r2 = blk_sum(r2, sh); dbg_report(ws, slot, e2, r2);
    if (threadIdx.x == 0 && sqrtf(e2 / fmaxf(r2, 1e-30f)) > 0.03f) atomicAdd((unsigned*)ws + DBG_W + 16 + ((r % T) < 256 ? 0 : 1), 1u);
}
__global__ void __launch_bounds__(512) dbg_rms256(const unsigned short* Hh, const float* gpre, const float* win, int coff, const float* gain, const unsigned short* O, unsigned char* ws, int slot) {
    __shared__ float arow[1024]; __shared__ float sh[8];
    const int r = dbg_row(blockIdx.x), tid = threadIdx.x;
    for (int k = tid; k < 1024; k += 512) arow[k] = bf2f(Hh[(size_t)r * 1024 + k]) * gpre[k];
    __syncthreads();
    float z = 0.f; if (tid < 256) for (int k = 0; k < 1024; ++k) z += arow[k] * win[(size_t)k * 5188 + coff + tid];
    const float ss = blk_sum(z * z, sh); const float rstd = 1.0f / sqrtf(ss / 256.f + 1e-6f);
    float e = 0.f, rr = 0.f; if (tid < 256) { const float v = z * rstd * (gain ? gain[tid] : 1.f); const float dd = v - bf2f(O[(size_t)r * 256 + tid]); e = dd * dd; rr = v * v; }
    e = blk_sum(e, sh); rr = blk_sum(rr, sh); dbg_report(ws, slot, e, rr);
}
__global__ void __launch_bounds__(512) dbg_kidx(const unsigned short* Hh, const float* gpre, const float* win, const float* lg, const float* lb, const unsigned short* KIDX, const float* WIDX, unsigned char* ws, int slot) {
    __shared__ float arow[1024]; __shared__ float sh[8];
    const int r = dbg_row(blockIdx.x), tid = threadIdx.x;
    for (int k = tid; k < 1024; k += 512) arow[k] = bf2f(Hh[(size_t)r * 1024 + k]) * gpre[k];
    __syncthreads();
    float z = 0.f; if (tid < 68) for (int k = 0; k < 1024; ++k) z += arow[k] * win[(size_t)k * 5188 + 512 + tid];
    const float mean = blk_sum(tid < 64 ? z : 0.f, sh) / 64.f; const float xc = tid < 64 ? z - mean : 0.f; const float var = blk_sum(xc * xc, sh) / 64.f;
    float e = 0.f, rr = 0.f;
    if (tid < 64) { const float v = xc / sqrtf(var + 1e-6f) * lg[tid] + lb[tid]; const float dd = v - bf2f(KIDX[(size_t)r * 64 + tid]); e = dd * dd; rr = v * v; }
    else if (tid < 68) { const float v = z * 0.5f; const float dd = v - WIDX[(size_t)r * 4 + tid - 64]; e = dd * dd; rr = v * v; }
    e = blk_sum(e, sh); rr = blk_sum(rr, sh); dbg_report(ws, slot, e, rr);
}
__global__ void __launch_bounds__(512) dbg_memattn(const unsigned short* QM, const unsigned short* MK, const unsigned short* MVT, const unsigned short* ACT, unsigned char* ws, int slot) {
    __shared__ float s[4][256]; __shared__ float sh[8];
    const int tok = dbg_row(blockIdx.x), tid = threadIdx.x, b = tok / T, h = tid >> 7, dcol = tid & 127;
    for (int i = 0; i < 2; ++i) { const int idx = tid + 512 * i, hh = idx >> 8, m = idx & 255; float a = 0.f;
        for (int dd = 0; dd < 128; ++dd) a += bf2f(QM[(size_t)tok * 512 + hh * 128 + dd]) * bf2f(MK[(size_t)(b * 256 + m) * 512 + hh * 128 + dd]);
        s[hh][m] = a; }
    __syncthreads();
    float mx = -INFINITY; for (int m = 0; m < 256; ++m) mx = fmaxf(mx, s[h][m]);
    float l = 0.f, o = 0.f; for (int m = 0; m < 256; ++m) { const float p = exp2f(s[h][m] - mx); l += p; o += p * bf2f(MVT[(size_t)(h * 128 + dcol) * (NB * 256) + b * 256 + m]); }
    o /= l; const float dd = o - bf2f(ACT[(size_t)tok * 1536 + 1024 + tid]);
    const float e = blk_sum(dd * dd, sh), rr = blk_sum(o * o, sh); dbg_report(ws, slot, e, rr);
}
__global__ void __launch_bounds__(512) dbg_dsa(const unsigned short* Q, const unsigned short* KP, const unsigned short* VP, const unsigned short* QIDX, const unsigned short* KIDX, const float* WIDX, const unsigned short* ACT, unsigned char* ws, int slot) {
    __shared__ float sc[2048]; __shared__ unsigned char selflag[2048]; __shared__ float sh[8];
    const int tok = dbg_row(blockIdx.x), tid = threadIdx.x, b = tok / T, t = tok % T; const size_t tokb = (size_t)b * T;
    for (int key = tid; key <= t; key += 512) { float tot = 0.f;
        for (int hh = 0; hh < 4; ++hh) { float a = 0.f; for (int dd = 0; dd < 64; ++dd) a += bf2f(QIDX[(size_t)tok * 256 + hh * 64 + dd]) * bf2f(KIDX[(tokb + key) * 64 + dd]); tot += WIDX[(size_t)tok * 4 + hh] * fmaxf(a, 0.f); }
        sc[key] = tot; }
    __syncthreads();
    for (int key = tid; key <= t; key += 512) { int rank = 0; const float v = sc[key]; for (int k2 = 0; k2 <= t; ++k2) { const float w = sc[k2]; rank += (w > v || (w == v && k2 < key)) ? 1 : 0; } selflag[key] = rank < 256 ? 1 : 0; }
    __syncthreads();
    const int h = tid >> 6; float mx = -INFINITY, l = 0.f, o = 0.f;
    for (int key = 0; key <= t; ++key) { if (!selflag[key]) continue; float a = 0.f;
        for (int dd = 0; dd < 64; ++dd) a += bf2f(Q[(size_t)tok * 512 + h * 64 + dd]) * bf2f(KP[(tokb + key) * 512 + h * 64 + dd]);
        const float mn = fmaxf(mx, a), f = expf(mx - mn), p = expf(a - mn); l = l * f + p; o = o * f + p * bf2f(VP[(tokb + key) * 512 + tid]); mx = mn; }
    o /= l; const float dd = o - bf2f(ACT[(size_t)tok * 1536 + tid]);
    const float e = blk_sum(dd * dd, sh), rr = blk_sum(o * o, sh); dbg_report(ws, slot, e, rr);
}

__global__ void __launch_bounds__(512) dbg_lin_t(const unsigned short* A, int K, const unsigned short* WT, int N, const unsigned short* O, int ldo, int act, unsigned char* ws, int slot) {
    __shared__ float arow[1024]; __shared__ float sh[8];
    const int r = dbg_row(blockIdx.x), tid = threadIdx.x;
    for (int k = tid; k < K; k += 512) arow[k] = bf2f(A[(size_t)r * K + k]);
    __syncthreads();
    float e2 = 0.f, r2 = 0.f;
    for (int n = tid; n < N; n += 512) { float y = 0.f; for (int k = 0; k < K; ++k) y += arow[k] * bf2f(WT[(size_t)n * K + k]);
        if (act == 1) y = 1.f / (1.f + expf(-y));
        const float dd = y - bf2f(O[(size_t)r * ldo + n]); e2 += dd * dd; r2 += y * y; }
    e2 = blk_sum(e2, sh); r2 = blk_sum(r2, sh); dbg_report(ws, slot, e2, r2);
}
__global__ void __launch_bounds__(512) dbg_wt(const unsigned short* WT, int K, const float* W, int ldw, int coff, const float* gsc, unsigned char* ws, int slot) {
    __shared__ float sh[8];
    const int n = blockIdx.x, tid = threadIdx.x; float e2 = 0.f, r2 = 0.f;
    for (int k = tid; k < K; k += 512) { const float v = W[(size_t)k * ldw + coff + n] * (gsc ? gsc[k] : 1.f); const float dd = v - bf2f(WT[(size_t)n * K + k]); e2 += dd * dd; r2 += v * v; }
    e2 = blk_sum(e2, sh); r2 = blk_sum(r2, sh); dbg_report(ws, slot, e2, r2);
}

__global__ void __launch_bounds__(256) dbg_tile(const unsigned short* A, const unsigned short* WT, const unsigned short* O, unsigned char* ws) {
    __shared__ float arow[1024]; __shared__ float sh2[4]; __shared__ float sh3[4];
    const int r = dbg_row(blockIdx.x / 12), pn = blockIdx.x % 12, tid = threadIdx.x, n = pn * 256 + tid;
    for (int k = tid; k < 1024; k += 256) arow[k] = bf2f(A[(size_t)r * 1024 + k]);
    __syncthreads();
    float y = 0.f; for (int k = 0; k < 1024; ++k) y += arow[k] * bf2f(WT[(size_t)n * 1024 + k]);
    if (MK_DBG_SIG) y = 1.f / (1.f + expf(-y));
    const float dd = y - bf2f(O[(size_t)r * 3072 + n]);
    float e2 = wave_sum(dd * dd), r2 = wave_sum(y * y);
    if ((tid & 63) == 0) { sh2[tid >> 6] = e2; sh3[tid >> 6] = r2; }
    __syncthreads();
    if (tid == 0) { e2 = sh2[0] + sh2[1] + sh2[2] + sh2[3]; r2 = sh3[0] + sh3[1] + sh3[2] + sh3[3];
        if (sqrtf(e2 / r2) > 0.03f) { const int pm = r / 256; int fi = 7;
            for (int c = 0; c < 256; ++c) { pg8::StaticOrder S; S.init(NT, 3072, 256, c); pg8::Unit u; for (int i = 0; S.next(i, u); ++i) if (u.pm == pm && u.pn == pn) fi = i; }
            atomicAdd((unsigned*)ws + DBG_W + 24 + fi, 1u); atomicAdd((unsigned*)ws + DBG_W + 23, 1u); } }
}

__global__ void __launch_bounds__(256) dbg_gates_naive(const unsigned short* A, const unsigned short* WT, unsigned short* O) {
    __shared__ float arow[8][1024];
    const int r0 = (blockIdx.x / 12) * 8, n = (blockIdx.x % 12) * 256 + threadIdx.x;
    for (int i = threadIdx.x; i < 8 * 1024; i += 256) arow[i >> 10][i & 1023] = bf2f(A[(size_t)(r0 + (i >> 10)) * 1024 + (i & 1023)]);
    __syncthreads();
    float acc[8] = {0.f, 0.f, 0.f, 0.f, 0.f, 0.f, 0.f, 0.f};
    const v4u* wp = (const v4u*)(WT + (size_t)n * 1024);
    for (int k8 = 0; k8 < 128; ++k8) { const v4u w = wp[k8];
#pragma unroll
        for (int e = 0; e < 4; ++e) { const float w0 = pg8::bf_lo(w[e]), w1 = pg8::bf_hi(w[e]);
#pragma unroll
            for (int i = 0; i < 8; ++i) acc[i] += arow[i][8 * k8 + 2 * e] * w0 + arow[i][8 * k8 + 2 * e + 1] * w1; } }
#pragma unroll
    for (int i = 0; i < 8; ++i) O[(size_t)(r0 + i) * 3072 + n] = (unsigned short)f2bf(1.f / (1.f + expf(-acc[i])));
}
__global__ void dbg_cmp_mask(const unsigned long long* a, const unsigned long long* b2, unsigned char* ws) {
    const size_t n = (size_t)NB * 32 * T; unsigned bad = 0u, nz = 0u;
    for (size_t i = (size_t)blockIdx.x * blockDim.x + threadIdx.x; i < n; i += (size_t)gridDim.x * blockDim.x) { if (a[i] != b2[i]) ++bad; if (b2[i] != 0ull) ++nz; }
    if (bad) atomicAdd((unsigned*)ws + DBG_W + 23, bad);
    if (nz) atomicAdd((unsigned*)ws + DBG_W + 22, nz);
}
__global__ void dbg_apply(float* out, const unsigned char* ws, float t0, float t1, float t2, float t3) {
    const unsigned* w = (const unsigned*)ws + DBG_W; float delta = 0.f;
    if (MK_SEL_BP) { delta += 0.02f; if (w[22] < 100000u) delta += 0.4f; }
    if (w[23] > 0u) delta += 0.1f; if (w[23] > 100u) delta += 0.2f; if (w[23] > 1228u) delta += 0.4f;
    const size_t n = (size_t)NT * D; for (size_t i = (size_t)blockIdx.x * blockDim.x + threadIdx.x; i < n; i += (size_t)gridDim.x * blockDim.x) out[i] *= (1.f + delta);
}
#endif

extern "C" void kernel_launch(void* const* d_in, const int* in_sizes, int n_in, void* d_out, int out_size, void* d_ws, size_t ws_size, hipStream_t stream) {
    static int grid = 0;
    if (grid == 0) {
        if (n_in != 31 || out_size != NT * D || ws_size < WS_END) { fprintf(stderr, "kernel_launch: unexpected problem (n_in %d out %d ws %zu)\n", n_in, out_size, ws_size); grid = -1; return; }
        int dev = 0, cus = 0, per_cu = 0;
        if (hipGetDevice(&dev) != hipSuccess || hipDeviceGetAttribute(&cus, hipDeviceAttributeMultiprocessorCount, dev) != hipSuccess) { grid = -1; return; }
        if (hipFuncSetAttribute((const void*)mk_fwd, hipFuncAttributeMaxDynamicSharedMemorySize, LDS_BYTES) != hipSuccess) { fprintf(stderr, "kernel_launch: hipFuncSetAttribute failed\n"); grid = -1; return; }
        if (hipOccupancyMaxActiveBlocksPerMultiprocessor(&per_cu, (const void*)mk_fwd, NWAVES * 64, LDS_BYTES) != hipSuccess || per_cu < 1) { fprintf(stderr, "kernel_launch: occupancy query says %d\n", per_cu); per_cu = 1; }
        (void)hipGetLastError();
        grid = cus;
        if (grid != 256) fprintf(stderr, "kernel_launch: note: %d CUs\n", grid);
    }
    if (grid < 0) return;
    (void)hipMemsetAsync((char*)d_ws + WS_CTL, 0, CTL_ZERO_BYTES, stream);
    Args a{};
    for (int i = 0; i < 31; ++i) a.in[i] = (const float*)d_in[i];
    a.out = (float*)d_out; a.ws = (unsigned char*)d_ws;
#if MK_ONE_LAUNCH
    a.ph_lo = 0; a.ph_hi = N_PHASES;
    void* kargs[] = {&a};
    hipError_t e = hipLaunchCooperativeKernel((const void*)mk_fwd, dim3(grid), dim3(NWAVES * 64), kargs, LDS_BYTES, stream);
    if (e != hipSuccess) fprintf(stderr, "kernel_launch: cooperative launch failed: %s\n", hipGetErrorString(e));
#else
    for (int p = 0; p < N_PHASES; ++p) { a.ph_lo = p; a.ph_hi = p + 1; hipLaunchKernelGGL(mk_fwd, dim3(grid), dim3(NWAVES * 64), LDS_BYTES, stream, a);
#if MK_DEBUG
        unsigned char* ws = (unsigned char*)d_ws; const float* const* in = (const float* const*)a.in;
        typedef const unsigned short* cus;
        if (p == 6 && MK_SEL_BP) hipLaunchKernelGGL(dbg_cmp_mask, dim3(1024), dim3(256), 0, stream, (const unsigned long long*)(ws + WS_MASKT), (const unsigned long long*)(ws + WS_END), ws);
        if (p == 7 && !MK_SEL_BP) hipLaunchKernelGGL(dbg_tile, dim3(2048 * 12), dim3(256), 0, stream, (cus)(ws + WS_H), (cus)(ws + WS_WIN) + (size_t)2304 * 1024, (cus)(ws + WS_BIG), ws);
        if (p == N_PHASES - 1) hipLaunchKernelGGL(dbg_apply, dim3(1024), dim3(256), 0, stream, (float*)d_out, ws, 0.03f, 0.03f, 0.03f, 0.03f);
#endif
    }
#endif
}
```
